# Optimizing an MI355X kernel written in HIP

```python
import math, functools
import jax, jax.numpy as jnp
from jax import lax
import numpy as np

D_MODEL = 1024
BATCH = 8
SEQ = 2048
DEPTH = 4
DEC_BATCH = 32
DEC_SEQ = 32
PAST_LEN = 2048

CHUNK = 64
HEAD_DIM = 64
A_WIDTH = 256
A_GROUPS = 4
A_GROUP_DIM = A_WIDTH // A_GROUPS
A_CHUNK = 128
B_HEADS = 8
B_KV_HEADS = 2
B_GROUP = B_HEADS // B_KV_HEADS
B_WIDTH = B_HEADS * HEAD_DIM
B_KV_WIDTH = B_KV_HEADS * HEAD_DIM
B_WINDOW = 128
B_PREV = B_WINDOW // CHUNK
C_HEADS = 4
C_WIDTH = C_HEADS * HEAD_DIM
C_PREV = 8
C_REACH = C_PREV * CHUNK
C_REL_CLIP = 128
T5_BUCKETS = 32
T5_MAX_DIST = 128

MIX_WIDTH = A_WIDTH + B_WIDTH + C_WIDTH
PROJ_SIZES = [A_WIDTH, A_WIDTH, A_WIDTH,
              B_WIDTH, B_KV_WIDTH, B_KV_WIDTH, B_WIDTH,
              C_WIDTH, C_WIDTH, C_WIDTH, C_WIDTH]
PROJ_SPLITS = [int(s) for s in np.cumsum(PROJ_SIZES)[:-1]]
IN_WIDTH = int(sum(PROJ_SIZES))
RMS_EPS = 1e-6
NEG_INF = -1e30

kernel_name = "hybrid_streaming_encoder_step"


def rmsnorm(x, g):
    x32 = x.astype(jnp.float32)
    y = x32 * lax.rsqrt(jnp.mean(x32 * x32, axis=-1, keepdims=True) + RMS_EPS)
    return (y * g.astype(jnp.float32)).astype(x.dtype)


def t5_bucket(rel):
    half = T5_BUCKETS // 2
    max_exact = half // 2
    ret = jnp.where(rel > 0, half, 0)
    n = jnp.abs(rel)
    nf = jnp.maximum(n, 1).astype(jnp.float32)
    large = max_exact + (jnp.log(nf / max_exact) / math.log(T5_MAX_DIST / max_exact)
                         * (half - max_exact)).astype(jnp.int32)
    large = jnp.minimum(large, half - 1)
    return ret + jnp.where(n < max_exact, n, large)


def t5_bias_block(table, rel):
    b = table[t5_bucket(rel)].astype(jnp.float32)
    tq, l = rel.shape
    return jnp.transpose(b, (2, 0, 1)).reshape(B_KV_HEADS, B_GROUP, tq, l)


def c_bias_block(table, rel):
    idx = jnp.clip(rel, -C_REL_CLIP, C_REL_CLIP) + C_REL_CLIP
    b = table[idx].astype(jnp.float32)
    return jnp.transpose(b, (2, 0, 1))[:, None]


def band_rel(tq, length, n_past):
    return jnp.arange(length)[None, :] - n_past - jnp.arange(tq)[:, None]


def band_gather(x, n_prev):
    s = x.shape[1]
    n = s // CHUNK
    xp = jnp.pad(x, ((0, 0), (n_prev * CHUNK, 0), (0, 0), (0, 0)))
    idx = jnp.arange(n)[:, None] * CHUNK + jnp.arange((n_prev + 1) * CHUNK)[None, :]
    return xp[:, idx]


def band_valid(n, n_prev):
    length = (n_prev + 1) * CHUNK
    return (jnp.arange(n)[:, None] * CHUNK - n_prev * CHUNK + jnp.arange(length)[None, :]) >= 0


def block_attention(q, k, v, bias, valid, sinks):
    s = jnp.einsum('bnqhgd,bnlhd->bnhgql', q, k).astype(jnp.float32) * (HEAD_DIM ** -0.5) + bias
    if valid is not None:
        s = jnp.where(valid[None, :, None, None, None, :], s, NEG_INF)
    if sinks is None:
        p = jax.nn.softmax(s, axis=-1)
    else:
        sink = sinks.astype(jnp.float32).reshape(bias.shape[0], bias.shape[1], 1, 1)
        m = jnp.maximum(jnp.max(s, axis=-1, keepdims=True), sink)
        e = jnp.exp(s - m)
        p = e / (jnp.sum(e, axis=-1, keepdims=True) + jnp.exp(sink - m))
    return jnp.einsum('bnhgql,bnlhd->bnqhgd', p.astype(v.dtype), v)


def band_attention_prompt(q, k, v, n_prev, kv_heads, bias_fn, sinks, keep):
    bn, s, _ = q.shape
    n = s // CHUNK
    group = q.shape[-1] // (kv_heads * HEAD_DIM)
    qb = q.reshape(bn, n, CHUNK, kv_heads, group, HEAD_DIM)
    kh = k.reshape(bn, s, kv_heads, HEAD_DIM)
    vh = v.reshape(bn, s, kv_heads, HEAD_DIM)
    length = (n_prev + 1) * CHUNK
    bias = bias_fn(band_rel(CHUNK, length, n_prev * CHUNK))
    o = block_attention(qb, band_gather(kh, n_prev), band_gather(vh, n_prev),
                        bias, band_valid(n, n_prev), sinks)
    keep = min(keep, s)
    return o.reshape(bn, s, -1), kh[:, s - keep:], vh[:, s - keep:]


def band_attention_sample(q, k, v, cache_k, cache_v, kv_heads, bias_fn, sinks):
    bn, t, _ = q.shape
    group = q.shape[-1] // (kv_heads * HEAD_DIM)
    qb = q.reshape(bn, 1, t, kv_heads, group, HEAD_DIM)
    kn = k.reshape(bn, t, kv_heads, HEAD_DIM)
    vn = v.reshape(bn, t, kv_heads, HEAD_DIM)
    kk = jnp.concatenate([cache_k.astype(kn.dtype), kn], axis=1)[:, None]
    vv = jnp.concatenate([cache_v.astype(vn.dtype), vn], axis=1)[:, None]
    lc = cache_k.shape[1]
    bias = bias_fn(band_rel(t, lc + t, lc))
    o = block_attention(qb, kk, vv, bias, None, sinks)
    return o.reshape(bn, t, -1), kn, vn


def mixer_a(au, av, az, g_v, ws, bs, chunk_len):
    bn, s, _ = au.shape
    n = s // chunk_len
    vn = rmsnorm(av, g_v)
    shp = (bn, n, chunk_len, A_GROUPS, A_GROUP_DIM)
    w = jnp.tril(ws[:, :chunk_len, :chunk_len])
    mix = (jnp.einsum('gts,bnsgd->bntgd', w, vn.reshape(shp))
           + jnp.transpose(bs[:, :chunk_len])[None, None, :, :, None])
    y = (au.reshape(shp) * mix).reshape(bn, s, A_WIDTH)
    return y * jax.nn.silu(az), vn


def mixer_inputs(x, g_pre, w_in):
    h = rmsnorm(x, g_pre)
    return jnp.split(h @ w_in, PROJ_SPLITS, axis=-1)


def mixer_output(x, ya, yb, yc, w_out, g_post):
    y = jnp.concatenate([ya, yb, yc], axis=-1) @ w_out
    return x + rmsnorm(y, g_post)


def setup_inputs(seed: int = 0) -> dict:
    key = jax.random.key(seed)
    ks = jax.random.split(key, 18)
    b_keep = min(B_WINDOW, PAST_LEN)
    c_keep = min(C_REACH, PAST_LEN)
    nrm = jax.random.normal
    f32 = jnp.float32
    return {
        "x_prompt": nrm(ks[0], (BATCH, SEQ, D_MODEL), f32),
        "x_sample": nrm(ks[1], (DEC_BATCH, DEC_SEQ, D_MODEL), f32),
        "cache_b_k": nrm(ks[2], (DEPTH, DEC_BATCH, b_keep, B_KV_HEADS, HEAD_DIM), f32),
        "cache_b_v": nrm(ks[3], (DEPTH, DEC_BATCH, b_keep, B_KV_HEADS, HEAD_DIM), f32),
        "cache_c_k": nrm(ks[4], (DEPTH, DEC_BATCH, c_keep, C_HEADS, HEAD_DIM), f32),
        "cache_c_v": nrm(ks[5], (DEPTH, DEC_BATCH, c_keep, C_HEADS, HEAD_DIM), f32),
        "g_pre": 1.0 + 0.05 * nrm(ks[6], (DEPTH, D_MODEL), f32),
        "g_post": 1.0 + 0.05 * nrm(ks[7], (DEPTH, D_MODEL), f32),
        "w_in": nrm(ks[8], (DEPTH, D_MODEL, IN_WIDTH), f32) * D_MODEL ** -0.5,
        "w_out": nrm(ks[9], (DEPTH, MIX_WIDTH, D_MODEL), f32) * MIX_WIDTH ** -0.5,
        "a_norm_g": 1.0 + 0.05 * nrm(ks[10], (DEPTH, A_WIDTH), f32),
        "a_ws": nrm(ks[11], (DEPTH, A_GROUPS, A_CHUNK, A_CHUNK), f32) * A_CHUNK ** -0.5,
        "a_bs": 1.0 + 0.05 * nrm(ks[12], (DEPTH, A_GROUPS, A_CHUNK), f32),
        "b_sinks": nrm(ks[13], (DEPTH, B_HEADS), f32),
        "c_rel_bias": 0.1 * nrm(ks[14], (DEPTH, 2 * C_REL_CLIP + 1, C_HEADS), f32),
        "t5_bias": 0.1 * nrm(ks[15], (T5_BUCKETS, B_HEADS), f32),
    }


def reference(x_prompt, x_sample, cache_b_k, cache_b_v, cache_c_k, cache_c_v,
              g_pre, g_post, w_in, w_out, a_norm_g, a_ws, a_bs, b_sinks,
              c_rel_bias, t5_bias):
    t5_fn = functools.partial(t5_bias_block, t5_bias)
    xp, xs = x_prompt, x_sample
    bkp, bvp, ckp, cvp = [], [], [], []
    bks, bvs, cks, cvs, avs = [], [], [], [], []
    for l in range(DEPTH):
        c_fn = functools.partial(c_bias_block, c_rel_bias[l])
        au, av, az, bq, bk, bv, bz, cq, ck, cv, cz = mixer_inputs(xp, g_pre[l], w_in[l])
        ya, _ = mixer_a(au, av, az, a_norm_g[l], a_ws[l], a_bs[l], A_CHUNK)
        yb, kb, vb = band_attention_prompt(bq, bk, bv, B_PREV, B_KV_HEADS, t5_fn, b_sinks[l], B_WINDOW)
        yc, kc, vc = band_attention_prompt(cq, ck, cv, C_PREV, C_HEADS, c_fn, None, C_REACH)
        xp = mixer_output(xp, ya, yb * jax.nn.silu(bz), yc * jax.nn.silu(cz), w_out[l], g_post[l])
        bkp.append(kb); bvp.append(vb); ckp.append(kc); cvp.append(vc)
        au, av, az, bq, bk, bv, bz, cq, ck, cv, cz = mixer_inputs(xs, g_pre[l], w_in[l])
        ya, va = mixer_a(au, av, az, a_norm_g[l], a_ws[l], a_bs[l], xs.shape[1])
        yb, kb, vb = band_attention_sample(bq, bk, bv, cache_b_k[l], cache_b_v[l], B_KV_HEADS, t5_fn, b_sinks[l])
        yc, kc, vc = band_attention_sample(cq, ck, cv, cache_c_k[l], cache_c_v[l], C_HEADS, c_fn, None)
        xs = mixer_output(xs, ya, yb * jax.nn.silu(bz), yc * jax.nn.silu(cz), w_out[l], g_post[l])
        bks.append(kb); bvs.append(vb); cks.append(kc); cvs.append(vc); avs.append(va)
    return (xp, xs,
            jnp.stack(bkp), jnp.stack(bvp), jnp.stack(ckp), jnp.stack(cvp),
            jnp.stack(bks), jnp.stack(bvs), jnp.stack(cks), jnp.stack(cvs), jnp.stack(avs))
```

```cpp
#include <hip/hip_runtime.h>
#include <cstdio>
#include <cstdint>

constexpr int D = 1024, NPROMPT = 8 * 2048, NSAMP = 32 * 32, M = NPROMPT + NSAMP  , NIN = 3072, DEPTH = 4, SEQ = 2048;
constexpr float RMS_EPS = 1e-6f;
constexpr int PC_AU = 0, PC_AV = 256, PC_AZ = 512, PC_BQ = 768, PC_BK = 1280, PC_BV = 1408, PC_BZ = 1536, PC_CQ = 2048, PC_CK = 2304, PC_CV = 2560, PC_CZ = 2816;
constexpr int YC_A = 0, YC_B = 256, YC_C = 768;
constexpr size_t O_YP = 0, O_YS = 16777216, O_BKP = 17825792, O_BVP = 18350080, O_CKP = 18874368, O_CVP = 23068672, O_BKS = 27262976, O_BVS = 27787264, O_CKS = 28311552, O_CVS = 29360128, O_AVS = 30408704, O_END = 31457280;

namespace pg8 {
#define PG8_LAS __attribute__((address_space(3)))
typedef unsigned short bf16_t;
typedef short bf16x8 __attribute__((ext_vector_type(8)));
typedef float f32x4 __attribute__((ext_vector_type(4)));
typedef unsigned u32x4 __attribute__((ext_vector_type(4)));
constexpr int BM = 256, BK = 64, HALF = 128, HTB = HALF * BK * 2  , STAGE_BYTES = 8 * HTB, NXCD = 8, WGM = 8;

__host__ __device__ __forceinline__ int lds_byte(int r, int c) { const int st = (r >> 4) * 2 + (c >> 5), rr = r & 15, cc = c & 31, ob = rr * 64 + cc * 2; return st * 1024 + (ob ^ (((ob >> 9) & 1) << 5)); }
__host__ __device__ __forceinline__ void stage_rc(int b, int& R, int& C) { const int st = b / 1024, sb = b % 1024, swz = sb ^ (((sb >> 9) & 1) << 5); R = (st >> 1) * 16 + swz / 64; C = (st & 1) * 32 + (swz % 64) / 2; }
__host__ __device__ __forceinline__ int perm32(int rho) { const int n = rho >> 4, i = rho & 15; return 8 * (i >> 2) + 4 * n + (i & 3); }

struct Unit { int pm, pn; };
struct Gemm { const bf16_t* A; const bf16_t* Bt; int M, N, K; };

struct StaticOrder {
    int nM, nN, nwg, G, c;
    __host__ __device__ void init(int M, int N, int G_, int c_) { nM = M / BM; nN = N / BM; nwg = nM * nN; G = G_; c = c_; }
    __host__ __device__ bool next(int i, Unit& u) const {
        const long L = (long)i * G + c; if (L >= nwg) return false;
        int wgid = (int)L; { const int q = nwg / NXCD, r = nwg % NXCD, xcd = wgid % NXCD, off = wgid / NXCD; wgid = (xcd < r ? xcd * (q + 1) : r * (q + 1) + (xcd - r) * q) + off; }
        const int nig = WGM * nN, gid = wgid / nig, fm = gid * WGM, gsz = (nM - fm) < WGM ? (nM - fm) : WGM;
        u.pm = fm + ((wgid % nig) % gsz); u.pn = (wgid % nig) / gsz; return true;
    }
    __device__ __forceinline__ void a_ready(const Unit&) const {}
    __device__ __forceinline__ void done(const Unit&) const {}
};


__device__ __forceinline__ unsigned cvt_pk_bf16(float lo, float hi) { unsigned r; asm volatile("v_cvt_pk_bf16_f32 %0, %1, %2" : "=v"(r) : "v"(lo), "v"(hi)); return r; }

struct EpiP {
    static constexpr bool PERM = true, AFTER_DRAIN = false;
    bf16_t* O; float* out; int layer;
    __device__ __forceinline__ void operator()(const f32x4 (&acc)[2][2][4][2], const Unit& u, int wr, int wc, int fr, int fq) const {
        const int row0 = u.pm * BM + wr * 64 + fr; const int col0 = u.pn * BM + wc * 32 + 8 * fq;
#pragma unroll
        for (int ai = 0; ai < 2; ++ai)
#pragma unroll
            for (int m = 0; m < 4; ++m) { bf16_t* rowp = O + (size_t)(row0 + ai * HALF + m * 16) * NIN + col0;
#pragma unroll
                for (int bj = 0; bj < 2; ++bj) { const f32x4 v0 = acc[ai][bj][m][0], v1 = acc[ai][bj][m][1];
                    u32x4 w; w.x = cvt_pk_bf16(v0[0], v0[1]); w.y = cvt_pk_bf16(v0[2], v0[3]); w.z = cvt_pk_bf16(v1[0], v1[1]); w.w = cvt_pk_bf16(v1[2], v1[3]);
                    *(u32x4*)(rowp + bj * HALF) = w; } }
        if (u.pn == 5 || u.pn == 9 || u.pn == 10) {
            const int cc = wc * 32 + 8 * fq;
#pragma unroll
            for (int ai = 0; ai < 2; ++ai)
#pragma unroll
                for (int m = 0; m < 4; ++m) {
                    const int r = row0 + ai * HALF + m * 16;
                    float* d0 = nullptr; float* d1 = nullptr;
                    if (u.pn == 5) {
                        if (r >= NPROMPT) { const size_t o = ((size_t)layer * NSAMP + (r - NPROMPT)) * 128 + cc; d0 = out + O_BKS + o; d1 = out + O_BVS + o; }
                        else { const int t = r & (SEQ - 1), b = r >> 11; if (t >= SEQ - 128) { const size_t o = (((size_t)layer * 8 + b) * 128 + (t - (SEQ - 128))) * 128 + cc; d0 = out + O_BKP + o; d1 = out + O_BVP + o; } }
                    } else {
                        const size_t os = (u.pn == 9) ? O_CKS : O_CVS, op = (u.pn == 9) ? O_CKP : O_CVP;
                        if (r >= NPROMPT) { const size_t o = ((size_t)layer * NSAMP + (r - NPROMPT)) * 256 + cc; d0 = out + os + o; d1 = d0 + 128; }
                        else { const int t = r & (SEQ - 1), b = r >> 11; if (t >= SEQ - 512) { const size_t o = (((size_t)layer * 8 + b) * 512 + (t - (SEQ - 512))) * 256 + cc; d0 = out + op + o; d1 = d0 + 128; } }
                    }
                    if (d0) { *(f32x4*)(d0) = acc[ai][0][m][0]; *(f32x4*)(d0 + 4) = acc[ai][0][m][1]; *(f32x4*)(d1) = acc[ai][1][m][0]; *(f32x4*)(d1 + 4) = acc[ai][1][m][1]; }
                }
        }
    }
};
struct EpiF32 {
    static constexpr bool PERM = false, AFTER_DRAIN = false;
    float* C; int ldc;
    __device__ __forceinline__ void operator()(const f32x4 (&acc)[2][2][4][2], const Unit& u, int wr, int wc, int fr, int fq) const {
        const int row0 = u.pm * BM + wr * 64 + fr, col0 = u.pn * BM + wc * 32 + 4 * fq;
#pragma unroll
        for (int ai = 0; ai < 2; ++ai)
#pragma unroll
            for (int m = 0; m < 4; ++m) { float* rowp = C + (size_t)(row0 + ai * HALF + m * 16) * ldc + col0;
#pragma unroll
                for (int bj = 0; bj < 2; ++bj)
#pragma unroll
                    for (int n = 0; n < 2; ++n) *(f32x4*)(rowp + bj * HALF + n * 16) = acc[ai][bj][m][n]; }
    }
};

template <class Epi, class Sched, bool ALIGN_EPI = false, bool SP2 = false>
__device__ __forceinline__ void gemm_phase(PG8_LAS unsigned char* lds, const Gemm g, const Sched& S, const Epi& E) {
    const int tid = threadIdx.x, wid = __builtin_amdgcn_readfirstlane(tid >> 6), lane = tid & 63, wr = wid >> 2, wc = wid & 3, fr = lane & 15, fq = lane >> 4;
    const int K = g.K, nt = K / BK;
    unsigned voffA[2], voffB[2];
#pragma unroll
    for (int i = 0; i < 2; ++i) { int R, C; stage_rc(tid * 16 + i * 8192, R, C); const int Rb = Epi::PERM ? ((R & ~31) + perm32(R & 31)) : R;
        voffA[i] = (unsigned)(R * K + C) * 2u; voffB[i] = (unsigned)(Rb * K + C) * 2u; }
    const size_t kstep = (size_t)(BK * 2);
    const size_t hstep = (size_t)HALF * K * 2;
    const size_t tstep = 2 * hstep;
    const unsigned ldsw = (unsigned)wid * 1024u;
    const int aoff = lds_byte(wr * 64 + fr, fq * 8), boff = lds_byte(wc * 32 + fr, fq * 8);
#define PG8_SA(b, h) (((b) * 2 + (h)) * HTB)
#define PG8_SB(b, h) ((4 + (b) * 2 + (h)) * HTB)
#define PG8_STAGE(bufoff, gbase, voff) do { _Pragma("unroll") for (int _i = 0; _i < 2; ++_i) \
        __builtin_amdgcn_global_load_lds((const unsigned*)((const char*)(gbase) + (voff)[_i]), (PG8_LAS unsigned*)(lds + (bufoff) + ldsw + _i * 8192), 16, 0, 0); } while (0)
#define PG8_LDA(dst, b, h) do { _Pragma("unroll") for (int m = 0; m < 4; ++m) _Pragma("unroll") for (int k = 0; k < 2; ++k) dst[m][k] = *(const PG8_LAS bf16x8*)(lds + PG8_SA(b, h) + aoff + m * 2048 + k * 1024); } while (0)
#define PG8_LDB(dst, b, h) do { _Pragma("unroll") for (int n = 0; n < 2; ++n) _Pragma("unroll") for (int k = 0; k < 2; ++k) dst[n][k] = *(const PG8_LAS bf16x8*)(lds + PG8_SB(b, h) + boff + n * 2048 + k * 1024); } while (0)
#define PG8_MMA(ai, bj, At, Bt) do { __builtin_amdgcn_s_setprio(1); _Pragma("unroll") for (int m = 0; m < 4; ++m) _Pragma("unroll") for (int n = 0; n < 2; ++n) _Pragma("unroll") for (int k = 0; k < 2; ++k) \
        acc[ai][bj][m][n] = __builtin_amdgcn_mfma_f32_16x16x32_bf16(Bt[n][k], At[m][k], acc[ai][bj][m][n], 0, 0, 0); __builtin_amdgcn_s_setprio(0); } while (0)
#define PG8_WAIT_V(n) asm volatile("s_waitcnt vmcnt(" #n ")" ::: "memory")
#define PG8_WAIT_L(n) asm volatile("s_waitcnt lgkmcnt(" #n ")" ::: "memory")
#define PG8_BAR __builtin_amdgcn_s_barrier()
#define PG8_SCHED __builtin_amdgcn_sched_barrier(0)
    Unit cur, nxt; int ui = 0;
    if (!S.next(0, cur)) return;
    f32x4 acc[2][2][4][2];
#pragma unroll
    for (int a = 0; a < 2; ++a)
#pragma unroll
        for (int b = 0; b < 2; ++b)
#pragma unroll
            for (int m = 0; m < 4; ++m)
#pragma unroll
                for (int n = 0; n < 2; ++n) acc[a][b][m][n] = (f32x4){0.f, 0.f, 0.f, 0.f};
    bf16x8 At[4][2], B0[2][2], B1[2][2];
    const char* cA = (const char*)g.A + (size_t)cur.pm * tstep; const char* cB = (const char*)g.Bt + (size_t)cur.pn * tstep;
    S.a_ready(cur);
    if constexpr (SP2) {
        PG8_STAGE(PG8_SB(0, 0), cB, voffB); PG8_STAGE(PG8_SB(0, 1), cB + hstep, voffB); PG8_STAGE(PG8_SA(0, 0), cA, voffA); PG8_STAGE(PG8_SA(0, 1), cA + hstep, voffA);
        if (wr == 1) PG8_BAR;
        PG8_WAIT_V(2); PG8_BAR;
        PG8_STAGE(PG8_SB(1, 0), cB + kstep, voffB); PG8_STAGE(PG8_SA(1, 0), cA + kstep, voffA); PG8_STAGE(PG8_SB(1, 1), cB + hstep + kstep, voffB);
        PG8_WAIT_V(6); PG8_BAR;
    } else {
        PG8_STAGE(PG8_SB(0, 0), cB, voffB); PG8_STAGE(PG8_SA(0, 0), cA, voffA); PG8_STAGE(PG8_SB(0, 1), cB + hstep, voffB); PG8_STAGE(PG8_SA(0, 1), cA + hstep, voffA);
        if (wr == 1) PG8_BAR;
        PG8_WAIT_V(4); PG8_BAR;
        PG8_STAGE(PG8_SB(1, 0), cB + kstep, voffB); PG8_STAGE(PG8_SA(1, 0), cA + kstep, voffA); PG8_STAGE(PG8_SB(1, 1), cB + hstep + kstep, voffB);
        PG8_WAIT_V(6); PG8_BAR;
    }
    for (;;) {
        const bool has_next = S.next(ui + 1, nxt);
        const char* nA = has_next ? (const char*)g.A + (size_t)nxt.pm * tstep : cA; const char* nB = has_next ? (const char*)g.Bt + (size_t)nxt.pn * tstep : cB;
        for (int t = 0; t < nt; t += 2) {
            const bool last = (t == nt - 2);
            const char* a1 = cA + (size_t)(t + 1) * kstep;
            const char* a2 = last ? nA : cA + (size_t)(t + 2) * kstep; const char* b2 = last ? nB : cB + (size_t)(t + 2) * kstep;
            const char* a3 = a2 + kstep; const char* b3 = b2 + kstep;
            if (last && has_next) S.a_ready(nxt);
            if constexpr (SP2) {
            PG8_LDB(B0, 0, 0); PG8_LDB(B1, 0, 1); PG8_SCHED; PG8_LDA(At, 0, 0); PG8_STAGE(PG8_SA(1, 1), a1 + hstep, voffA);
            PG8_WAIT_V(8); PG8_WAIT_L(0); PG8_BAR; PG8_MMA(0, 0, At, B0); PG8_MMA(0, 1, At, B1); PG8_BAR; PG8_SCHED;
            PG8_LDA(At, 0, 1); PG8_STAGE(PG8_SB(0, 0), b2, voffB); PG8_STAGE(PG8_SB(0, 1), b2 + hstep, voffB); PG8_STAGE(PG8_SA(0, 0), a2, voffA);
            PG8_WAIT_V(8); PG8_WAIT_L(0); PG8_BAR; PG8_MMA(1, 0, At, B0); PG8_MMA(1, 1, At, B1); PG8_BAR; PG8_SCHED;
            PG8_LDB(B0, 1, 0); PG8_LDB(B1, 1, 1); PG8_SCHED; PG8_LDA(At, 1, 0); PG8_STAGE(PG8_SA(0, 1), a2 + hstep, voffA);
            PG8_WAIT_V(8); PG8_WAIT_L(0); PG8_BAR; PG8_MMA(0, 0, At, B0); PG8_MMA(0, 1, At, B1); PG8_BAR; PG8_SCHED;
            PG8_LDA(At, 1, 1); PG8_STAGE(PG8_SB(1, 0), b3, voffB); PG8_STAGE(PG8_SB(1, 1), b3 + hstep, voffB); PG8_STAGE(PG8_SA(1, 0), a3, voffA);
            PG8_WAIT_V(8); PG8_WAIT_L(0); PG8_BAR; PG8_MMA(1, 0, At, B0); PG8_MMA(1, 1, At, B1); PG8_BAR; PG8_SCHED;
            } else {
            PG8_LDB(B0, 0, 0); PG8_SCHED; PG8_LDA(At, 0, 0); PG8_STAGE(PG8_SA(1, 1), a1 + hstep, voffA);
            PG8_WAIT_L(8); PG8_BAR; PG8_WAIT_L(0); PG8_MMA(0, 0, At, B0); PG8_BAR; PG8_SCHED;
            PG8_LDB(B1, 0, 1); PG8_STAGE(PG8_SB(0, 0), b2, voffB);
            PG8_BAR; PG8_WAIT_L(0); PG8_MMA(0, 1, At, B1); PG8_BAR;
            PG8_LDA(At, 0, 1); PG8_STAGE(PG8_SA(0, 0), a2, voffA);
            PG8_BAR; PG8_WAIT_L(0); PG8_MMA(1, 0, At, B0); PG8_BAR; PG8_SCHED;
            PG8_STAGE(PG8_SB(0, 1), b2 + hstep, voffB);
            PG8_WAIT_V(6); PG8_BAR; PG8_MMA(1, 1, At, B1); PG8_BAR;
            PG8_LDB(B0, 1, 0); PG8_SCHED; PG8_LDA(At, 1, 0); PG8_STAGE(PG8_SA(0, 1), a2 + hstep, voffA);
            PG8_WAIT_L(8); PG8_BAR; PG8_WAIT_L(0); PG8_MMA(0, 0, At, B0); PG8_BAR; PG8_SCHED;
            PG8_LDB(B1, 1, 1); PG8_STAGE(PG8_SB(1, 0), b3, voffB);
            PG8_BAR; PG8_WAIT_L(0); PG8_MMA(0, 1, At, B1); PG8_BAR;
            PG8_LDA(At, 1, 1); PG8_STAGE(PG8_SA(1, 0), a3, voffA);
            PG8_BAR; PG8_WAIT_L(0); PG8_MMA(1, 0, At, B0); PG8_BAR; PG8_SCHED;
            PG8_STAGE(PG8_SB(1, 1), b3 + hstep, voffB);
            PG8_WAIT_V(6); PG8_BAR; PG8_MMA(1, 1, At, B1); PG8_BAR;
            }
        }
        if constexpr (ALIGN_EPI) { if (wr == 0) PG8_BAR; }
        if constexpr (!Epi::AFTER_DRAIN) { E(acc, cur, wr, wc, fr, fq); S.done(cur); }
        if (!has_next) break;
#pragma unroll
        for (int a = 0; a < 2; ++a)
#pragma unroll
            for (int b = 0; b < 2; ++b)
#pragma unroll
                for (int m = 0; m < 4; ++m)
#pragma unroll
                    for (int n = 0; n < 2; ++n) acc[a][b][m][n] = (f32x4){0.f, 0.f, 0.f, 0.f};
        cur = nxt; cA = nA; cB = nB; ++ui;
        if constexpr (ALIGN_EPI) { if (wr == 1) PG8_BAR; }
    }
    PG8_WAIT_V(0);
    if constexpr (!ALIGN_EPI) { if (wr == 0) PG8_BAR; }
    PG8_BAR;
    if constexpr (Epi::AFTER_DRAIN) { E.fused(acc, cur, wr, wc, fr, fq, lds, wid, lane); S.done(cur); }
#undef PG8_SA
#undef PG8_SB
#undef PG8_STAGE
#undef PG8_LDA
#undef PG8_LDB
#undef PG8_MMA
#undef PG8_WAIT_V
#undef PG8_WAIT_L
#undef PG8_BAR
#undef PG8_SCHED
}
}
#define GAS __attribute__((address_space(1)))
#define LAS __attribute__((address_space(3)))
typedef unsigned short bf16;
typedef unsigned v4u __attribute__((ext_vector_type(4)));
typedef float f32x4 __attribute__((ext_vector_type(4)));
typedef short bf16x8 __attribute__((ext_vector_type(8)));
typedef GAS unsigned gu32;
typedef GAS unsigned long long gu64;
#define RLX_AGENT __ATOMIC_RELAXED, __HIP_MEMORY_SCOPE_AGENT
#define LDS_WAIT() asm volatile("s_waitcnt lgkmcnt(0)" ::: "memory")
#define VM_WAIT() asm volatile("s_waitcnt vmcnt(0)" ::: "memory")
__device__ __forceinline__ unsigned long long rt() { return __builtin_amdgcn_s_memrealtime(); }
__device__ __forceinline__ unsigned f2bf(float f) { unsigned u = __builtin_bit_cast(unsigned, f); return (u + 0x7fffu + ((u >> 16) & 1u)) >> 16; }
__device__ __forceinline__ unsigned pk2(float lo, float hi) { return f2bf(lo) | (f2bf(hi) << 16); }

#define XB_TMO      128
#define XB_XCNT(j)  (256  + 64 * (j))
#define XB_XSUB(j)  (1280 + 64 * (j))
#define XB_XGEN(j)  (2304 + 64 * (j))
#define XB_TOP      3328
#define XB_TOPGEN   3392
#define XCD_BAR_WORDS 3456
#define XB_SPIN_CAP (1u << 18)

__device__ __forceinline__ unsigned xb_ld(unsigned* p)              { return __hip_atomic_load(p, __ATOMIC_RELAXED, __HIP_MEMORY_SCOPE_AGENT); }
__device__ __forceinline__ unsigned xb_add(unsigned* p, unsigned v) { return __hip_atomic_fetch_add(p, v, __ATOMIC_RELAXED, __HIP_MEMORY_SCOPE_AGENT); }
__device__ __forceinline__ unsigned xb_xcc_id() { return (unsigned)__builtin_amdgcn_s_getreg((3 << 11) | 20) & 0xFu; }
#define XB_SPIN(cond, bar) do { unsigned _sp = 0; while (cond) { __builtin_amdgcn_s_sleep(1); \
    if ((++_sp & 255u) == 0u) { if (xb_ld(&(bar)[XB_TMO])) break; if (_sp > XB_SPIN_CAP) { atomicAdd(&(bar)[XB_TMO], 1u); break; } } } } while (0)

struct XcdBarrier {
    unsigned* bar; unsigned x;
    volatile LAS unsigned* st;
};

__device__ __forceinline__ XcdBarrier xcd_barrier_post(unsigned* bar, volatile LAS unsigned* st) {
    XcdBarrier b; b.bar = bar; b.x = xb_xcc_id(); b.st = st;
    if (threadIdx.x == 0) (void)xb_add(&bar[XB_XCNT(b.x)], 1u);
    return b;
}
__device__ __forceinline__ void xcd_barrier_complete(unsigned* bar, unsigned x, unsigned& nloc, unsigned& nx) {
    const unsigned G = gridDim.x * gridDim.y * gridDim.z;
    unsigned sum, cnt, mine, sp = 0u;
    for (;;) {
        sum = 0u; cnt = 0u; mine = 0u;
#pragma unroll
        for (unsigned j = 0; j < 16; ++j) { const unsigned c = xb_ld(&bar[XB_XCNT(j)]); sum += c; cnt += (c > 0u) ? 1u : 0u; mine = (j == x) ? c : mine; }
        if (sum == G) break;
        __builtin_amdgcn_s_sleep(1);
        if ((++sp & 255u) == 0u) { if (xb_ld(&bar[XB_TMO])) break; if (sp > XB_SPIN_CAP) { atomicAdd(&bar[XB_TMO], 1u); break; } }
    }
    nloc = mine > 0u ? mine : 1u; nx = cnt > 0u ? cnt : 1u;
}

__device__ __forceinline__ void xcd_barrier(const XcdBarrier& b) {
    asm volatile("s_waitcnt vmcnt(0)" ::: "memory");
    __syncthreads();
    if (threadIdx.x == 0) {
        unsigned* bar = b.bar;
        __builtin_amdgcn_s_waitcnt(0);
        unsigned nloc = b.st[0], nx = b.st[1];
        if (nloc == 0u) { xcd_barrier_complete(bar, b.x, nloc, nx); b.st[0] = nloc; b.st[1] = nx; }
        const unsigned old = xb_add(&bar[XB_XSUB(b.x)], 1u);
        const unsigned gen = old / nloc;
        if (old + 1u == (gen + 1u) * nloc) {
            __builtin_amdgcn_fence(__ATOMIC_RELEASE, "agent");
            asm volatile("s_waitcnt vmcnt(0)" ::: "memory");
            const unsigned og = xb_add(&bar[XB_TOP], 1u);
            const unsigned tg = og / nx;
            if (og + 1u == (tg + 1u) * nx) xb_add(&bar[XB_TOPGEN], 1u);
            else XB_SPIN(xb_ld(&bar[XB_TOPGEN]) == tg, bar);
            __builtin_amdgcn_fence(__ATOMIC_ACQUIRE, "agent");
            xb_add(&bar[XB_XGEN(b.x)], 1u);
            asm volatile("s_waitcnt vmcnt(0)" ::: "memory");
        } else {
            XB_SPIN(xb_ld(&bar[XB_XGEN(b.x)]) == gen, bar);
            __builtin_amdgcn_fence(__ATOMIC_ACQUIRE, "agent");
            asm volatile("s_waitcnt vmcnt(0)" ::: "memory");
        }
    }
    __syncthreads();
}

constexpr size_t MiB = 1u << 20;
constexpr size_t WS_CTL = 0, CTL_ZERO_BYTES = 1 * MiB;
constexpr size_t WS_WIN = 2 * MiB;
constexpr size_t WS_WOUT = 26 * MiB;
constexpr size_t WS_XN = 34 * MiB;
constexpr size_t WS_P = 68 * MiB;
constexpr size_t WS_Y = 170 * MiB;
constexpr size_t WS_YF = WS_P;
constexpr size_t WS_END = 204 * MiB;
constexpr int CW_BAR = 4096;

constexpr int RING_OFF = 0, RING_BYTES = 131072;
constexpr int TAB_OFF = RING_BYTES;
constexpr int TAB_T5 = TAB_OFF, TAB_CREL = TAB_OFF + 1024, TAB_END = TAB_CREL + 4352;
constexpr int LDSCTL_OFF = TAB_END, MISC_OFF = LDSCTL_OFF + 320;
constexpr int LDS_BYTES = 147456;
static_assert(MISC_OFF + 128 <= LDS_BYTES, "LDS map");
constexpr int NWAVES = 8;

struct Args { const float* in[16]; float* out; unsigned char* ws; int ph_lo, ph_hi; };
struct Frame {
    LAS unsigned char* lds;
    volatile LAS unsigned* MISC;
    gu32* ctl;
    int tid, lane, wave;
    int vcu, G;
    float* out;
    bf16 *Win_t, *Wout_t, *XN, *P, *Y; float* YF;
};

__device__ __forceinline__ float bf2f(bf16 v) { return __builtin_bit_cast(float, (unsigned)v << 16); }
__device__ __forceinline__ float wave_sum(float v) {
#pragma unroll
    for (int o = 1; o < 64; o <<= 1) v += __shfl_xor(v, o);
    return v;
}
__device__ __forceinline__ void p0_transpose_item(const float* W, int K, int N, bf16* WT, LAS float* scr, int item, int lane) {
    const int nblk = N / 32, kb = item / nblk, nb = item % nblk, k0 = 64 * kb, n0 = 32 * nb;
#pragma unroll 8
    for (int i = 0; i < 32; ++i) { const int kk = 2 * i + (lane >> 5); scr[kk * 33 + (lane & 31)] = W[(size_t)(k0 + kk) * N + n0 + (lane & 31)]; }
    LDS_WAIT(); asm volatile("" ::: "memory");
    const int c = lane & 7;
#pragma unroll
    for (int j = 0; j < 4; ++j) { const int n = (lane >> 3) + 8 * j; const LAS float* s = scr + (8 * c) * 33 + n;
        v4u o; o.x = pk2(s[0 * 33], s[1 * 33]); o.y = pk2(s[2 * 33], s[3 * 33]); o.z = pk2(s[4 * 33], s[5 * 33]); o.w = pk2(s[6 * 33], s[7 * 33]);
        *(GAS v4u*)(WT + (size_t)(n0 + n) * K + k0 + 8 * c) = o; }
    LDS_WAIT(); asm volatile("" ::: "memory");
}
__device__ __forceinline__ void rms_row_to_bf16(int lane, const float* xrow, const float* g, bf16* orow) {
    const GAS f32x4* xr = (const GAS f32x4*)xrow + lane; const GAS f32x4* gr = (const GAS f32x4*)g + lane;
    f32x4 v[4]; float s = 0.f;
#pragma unroll
    for (int j = 0; j < 4; ++j) { v[j] = xr[64 * j]; s += (v[j].x * v[j].x + v[j].y * v[j].y) + (v[j].z * v[j].z + v[j].w * v[j].w); }
    const float rstd = 1.f / sqrtf(wave_sum(s) * (1.f / D) + RMS_EPS);
    GAS unsigned long long* o8 = (GAS unsigned long long*)orow + lane;
#pragma unroll
    for (int j = 0; j < 4; ++j) { const f32x4 gg = gr[64 * j];
        o8[64 * j] = (unsigned long long)pk2(v[j].x * rstd * gg.x, v[j].y * rstd * gg.y) | ((unsigned long long)pk2(v[j].z * rstd * gg.z, v[j].w * rstd * gg.w) << 32); }
}
__device__ __forceinline__ const float* x_in_row(const Args& A, int m) { return m < NPROMPT ? A.in[0] + (size_t)m * D : A.in[1] + (size_t)(m - NPROMPT) * D; }

__device__ __forceinline__ void p0_prologue(Frame& F, const Args& A) {
    LAS float* scr = (LAS float*)(F.lds + RING_OFF + F.wave * 16384);
    const int gw = F.vcu * NWAVES + F.wave, NGW = F.G * NWAVES;
    constexpr int I_IN = (D / 64) * (NIN / 32), I_OUT = (D / 64) * (D / 32);
    constexpr int NITEMS = DEPTH * (I_IN + I_OUT);
    for (int it = gw; it < NITEMS; it += NGW) {
        const int l = it / (I_IN + I_OUT); int r = it % (I_IN + I_OUT);
        if (r < I_IN) p0_transpose_item(A.in[8] + (size_t)l * D * NIN, D, NIN, F.Win_t + (size_t)l * NIN * D, scr, r, F.lane);
        else p0_transpose_item(A.in[9] + (size_t)l * D * D, D, D, F.Wout_t + (size_t)l * D * D, scr, r - I_IN, F.lane);
    }
    for (int m = gw; m < M; m += NGW) rms_row_to_bf16(F.lane, x_in_row(A, m), A.in[6], F.XN + (size_t)m * D);
}

__device__ __forceinline__ void post_phase(Frame& F, const Args& A, int layer) {
    const int gw = F.vcu * NWAVES + F.wave, NGW = F.G * NWAVES; const int lane = F.lane;
    const GAS f32x4* gp = (const GAS f32x4*)(A.in[7] + (size_t)layer * D) + lane;
    const GAS f32x4* gn = (const GAS f32x4*)(A.in[6] + (size_t)(layer + 1 < DEPTH ? layer + 1 : 0) * D) + lane;
    for (int m = gw; m < M; m += NGW) {
        const GAS f32x4* yr = (const GAS f32x4*)(F.YF + (size_t)m * D) + lane;
        const GAS f32x4* xr = (const GAS f32x4*)(layer == 0 ? x_in_row(A, m) : F.out + (size_t)m * D) + lane;
        GAS f32x4* xo = (GAS f32x4*)(F.out + (size_t)m * D) + lane;
        f32x4 y[4], x[4]; float s = 0.f;
#pragma unroll
        for (int j = 0; j < 4; ++j) { y[j] = yr[64 * j]; x[j] = xr[64 * j]; s += (y[j].x * y[j].x + y[j].y * y[j].y) + (y[j].z * y[j].z + y[j].w * y[j].w); }
        const float rstd = 1.f / sqrtf(wave_sum(s) * (1.f / D) + RMS_EPS); float s2 = 0.f;
#pragma unroll
        for (int j = 0; j < 4; ++j) { const f32x4 g = gp[64 * j]; x[j] = x[j] + y[j] * rstd * g; xo[64 * j] = x[j]; s2 += (x[j].x * x[j].x + x[j].y * x[j].y) + (x[j].z * x[j].z + x[j].w * x[j].w); }
        if (layer + 1 < DEPTH) {
            const float r2 = 1.f / sqrtf(wave_sum(s2) * (1.f / D) + RMS_EPS);
            GAS unsigned long long* o8 = (GAS unsigned long long*)(F.XN + (size_t)m * D) + lane;
#pragma unroll
            for (int j = 0; j < 4; ++j) { const f32x4 g = gn[64 * j];
                o8[64 * j] = (unsigned long long)pk2(x[j].x * r2 * g.x, x[j].y * r2 * g.y) | ((unsigned long long)pk2(x[j].z * r2 * g.z, x[j].w * r2 * g.w) << 32); }
        }
    }
}

__device__ __forceinline__ float silu_f(float z) { return z / (1.f + __expf(-z)); }
__device__ __forceinline__ int t5_bucket(int rel) {
    const int n = rel < 0 ? -rel : rel;
    const int lg = 8 + (n >= 12) + (n >= 16) + (n >= 23) + (n >= 32) + (n >= 46) + (n >= 64) + (n >= 91);
    return (rel > 0 ? 16 : 0) + (n < 8 ? n : lg);
}
__device__ __forceinline__ void attn_simple(Frame& F, const Args& A, LAS float* scr, const LAS float* T5, const LAS float* CR, int lane, int KIND,
        int qrow, int qcol, int h, int qpos, bool writer,
        int nct, const float* cK, const float* cV, int cstride,
        int npt, int prow0, int kcol, int vcol,
        int kpos0,
        float sink, bool has_sink, int zcol, int ycol) {
    LAS float* Kl = scr; LAS float* Vl = scr + 2048;
    float q[64], o[64];
    { const bf16* qp = F.P + (size_t)qrow * NIN + qcol;
#pragma unroll
      for (int d8 = 0; d8 < 8; ++d8) { const v4u w = *(const GAS v4u*)(qp + 8 * d8);
          q[8 * d8 + 0] = __builtin_bit_cast(float, w.x << 16) * 0.125f; q[8 * d8 + 1] = __builtin_bit_cast(float, w.x & 0xffff0000u) * 0.125f;
          q[8 * d8 + 2] = __builtin_bit_cast(float, w.y << 16) * 0.125f; q[8 * d8 + 3] = __builtin_bit_cast(float, w.y & 0xffff0000u) * 0.125f;
          q[8 * d8 + 4] = __builtin_bit_cast(float, w.z << 16) * 0.125f; q[8 * d8 + 5] = __builtin_bit_cast(float, w.z & 0xffff0000u) * 0.125f;
          q[8 * d8 + 6] = __builtin_bit_cast(float, w.w << 16) * 0.125f; q[8 * d8 + 7] = __builtin_bit_cast(float, w.w & 0xffff0000u) * 0.125f; } }
#pragma unroll
    for (int d = 0; d < 64; ++d) o[d] = 0.f;
    float mrun = has_sink ? sink : -1e30f, lrun = has_sink ? 1.f : 0.f;
    const int nt = nct + npt;
    for (int t = 0; t < nt; ++t) {
        asm volatile("s_waitcnt lgkmcnt(0)" ::: "memory");
        if (t < nct) { const float* kp = cK + (size_t)(t * 32) * cstride + lane; const float* vp = cV + (size_t)(t * 32) * cstride + lane;
#pragma unroll 4
            for (int e = 0; e < 32; ++e) { Kl[e * 64 + lane] = kp[(size_t)e * cstride]; Vl[e * 64 + lane] = vp[(size_t)e * cstride]; }
        } else { const bf16* kp = F.P + (size_t)(prow0 + (t - nct) * 32) * NIN + lane;
#pragma unroll 4
            for (int e = 0; e < 32; ++e) { Kl[e * 64 + lane] = bf2f(kp[(size_t)e * NIN + kcol]); Vl[e * 64 + lane] = bf2f(kp[(size_t)e * NIN + vcol]); }
        }
        asm volatile("s_waitcnt vmcnt(0) lgkmcnt(0)" ::: "memory");
        const int relb = kpos0 + t * 32 - qpos;
#pragma unroll 1
        for (int jj = 0; jj < 32; ++jj) {
            const LAS f32x4* k4 = (const LAS f32x4*)(Kl + jj * 64);
            float s0 = 0.f, s1 = 0.f;
#pragma unroll
            for (int d4 = 0; d4 < 16; d4 += 2) { const f32x4 a = k4[d4], b = k4[d4 + 1];
                s0 += q[4 * d4] * a.x + q[4 * d4 + 1] * a.y + q[4 * d4 + 2] * a.z + q[4 * d4 + 3] * a.w;
                s1 += q[4 * d4 + 4] * b.x + q[4 * d4 + 5] * b.y + q[4 * d4 + 6] * b.z + q[4 * d4 + 7] * b.w;
                if ((d4 & 3) == 2) asm volatile("" ::: "memory"); }
            const int rel = relb + jj;
            float bias;
            if (KIND == 0) bias = T5[t5_bucket(rel) * 8 + h];
            else { const int ci = (rel < -128 ? -128 : (rel > 128 ? 128 : rel)) + 128; bias = CR[ci * 4 + h]; }
            const float s = s0 + s1 + bias;
            if (s > mrun) { const float sc = __expf(mrun - s); lrun *= sc;
#pragma unroll
                for (int d = 0; d < 64; ++d) o[d] *= sc;
                mrun = s; }
            const float p = __expf(s - mrun); lrun += p;
            const LAS f32x4* v4 = (const LAS f32x4*)(Vl + jj * 64);
#pragma unroll
            for (int d4 = 0; d4 < 16; ++d4) { const f32x4 a = v4[d4]; o[4 * d4] += p * a.x; o[4 * d4 + 1] += p * a.y; o[4 * d4 + 2] += p * a.z; o[4 * d4 + 3] += p * a.w;
                if ((d4 & 3) == 3) asm volatile("" ::: "memory"); }
        }
    }
    const float inv = 1.f / lrun;
    if (writer) { const bf16* zp = F.P + (size_t)qrow * NIN + zcol; bf16* yp = F.Y + (size_t)qrow * D + ycol;
#pragma unroll
        for (int d8 = 0; d8 < 8; ++d8) { const v4u w = *(const GAS v4u*)(zp + 8 * d8); float z[8];
            z[0] = __builtin_bit_cast(float, w.x << 16); z[1] = __builtin_bit_cast(float, w.x & 0xffff0000u); z[2] = __builtin_bit_cast(float, w.y << 16); z[3] = __builtin_bit_cast(float, w.y & 0xffff0000u);
            z[4] = __builtin_bit_cast(float, w.z << 16); z[5] = __builtin_bit_cast(float, w.z & 0xffff0000u); z[6] = __builtin_bit_cast(float, w.w << 16); z[7] = __builtin_bit_cast(float, w.w & 0xffff0000u);
            v4u r; r.x = pk2(o[8 * d8] * inv * silu_f(z[0]), o[8 * d8 + 1] * inv * silu_f(z[1])); r.y = pk2(o[8 * d8 + 2] * inv * silu_f(z[2]), o[8 * d8 + 3] * inv * silu_f(z[3]));
            r.z = pk2(o[8 * d8 + 4] * inv * silu_f(z[4]), o[8 * d8 + 5] * inv * silu_f(z[5])); r.w = pk2(o[8 * d8 + 6] * inv * silu_f(z[6]), o[8 * d8 + 7] * inv * silu_f(z[7]));
            *(GAS v4u*)(yp + 8 * d8) = r; } }
}

__device__ __forceinline__ void mixa_simple(Frame& F, const Args& A, LAS float* scr, int lane, int layer, int T, int row0, int g, float* avs_out  ) {
    constexpr int TM = 128;
    LAS float* rs = scr;
    LAS float* wr = scr + 128;
    const int c = g * 64 + lane;
    for (int s = 0; s < T; ++s) {
        const unsigned long long w = *(const GAS unsigned long long*)(F.P + (size_t)(row0 + s) * NIN + PC_AV + 4 * lane);
        const float a = __builtin_bit_cast(float, (unsigned)w << 16), b = __builtin_bit_cast(float, (unsigned)w & 0xffff0000u), cc = __builtin_bit_cast(float, (unsigned)(w >> 32) << 16), dd = __builtin_bit_cast(float, (unsigned)(w >> 32) & 0xffff0000u);
        const float ss = wave_sum((a * a + b * b) + (cc * cc + dd * dd));
        if (lane == 0) rs[s] = 1.f / sqrtf(ss * (1.f / 256.f) + RMS_EPS);
    }
    asm volatile("s_waitcnt lgkmcnt(0)" ::: "memory");
    const float ga = A.in[10][(size_t)layer * 256 + c];
    float vn[TM];
    { const bf16* vp = F.P + (size_t)row0 * NIN + PC_AV + c;
#pragma unroll
      for (int s8 = 0; s8 < TM; s8 += 8) {
          if (s8 < T) {
#pragma unroll
              for (int s = s8; s < s8 + 8; ++s) vn[s] = bf2f(vp[(size_t)(s - s8) * NIN]) * rs[s] * ga;
              if (avs_out) {
#pragma unroll
                  for (int s = s8; s < s8 + 8; ++s) avs_out[(size_t)s * 256 + c] = vn[s];
              }
          } else {
#pragma unroll
              for (int s = s8; s < s8 + 8; ++s) vn[s] = 0.f;
          }
          vp += 8 * NIN; asm volatile("" : "+v"(vp) :: "memory"); } }
    const float* Wg = A.in[11] + ((size_t)layer * 4 + g) * 128 * 128; const float* bsg = A.in[12] + ((size_t)layer * 4 + g) * 128;
    for (int t = 0; t < T; ++t) {
        asm volatile("s_waitcnt lgkmcnt(0)" ::: "memory");
        for (int s = lane; s < TM; s += 64) wr[s] = (s <= t) ? Wg[(size_t)t * 128 + s] : 0.f;
        asm volatile("s_waitcnt vmcnt(0) lgkmcnt(0)" ::: "memory");
        float a0 = bsg[t], a1 = 0.f;
        const LAS f32x4* w4 = (const LAS f32x4*)wr;
#pragma unroll
        for (int s4 = 0; s4 < TM / 4; s4 += 2) { const f32x4 a = w4[s4], b = w4[s4 + 1];
            a0 += a.x * vn[4 * s4] + a.y * vn[4 * s4 + 1] + a.z * vn[4 * s4 + 2] + a.w * vn[4 * s4 + 3];
            a1 += b.x * vn[4 * s4 + 4] + b.y * vn[4 * s4 + 5] + b.z * vn[4 * s4 + 6] + b.w * vn[4 * s4 + 7];
            if ((s4 & 7) == 6) asm volatile("" ::: "memory"); }
        const bf16* pr = F.P + (size_t)(row0 + t) * NIN;
        const float y = bf2f(pr[PC_AU + c]) * (a0 + a1) * silu_f(bf2f(pr[PC_AZ + c]));
        F.Y[(size_t)(row0 + t) * D + YC_A + c] = (bf16)f2bf(y);
    }
}

constexpr int U_AP = 8 * 16 * 4, U_AS = 32 * 4, U_BP = 8 * 32 * 8, U_BS = 32 * 2 * 2, U_CP = 8 * 32 * 4, U_CS = 32 * 4;
constexpr int U_ATT = U_CP + U_BP + U_CS + U_BS, U_TOTAL = U_ATT + U_AP + U_AS;
template <int NW>
__device__ __forceinline__ void mix_phase_simple(Frame& F, const Args& A, int layer) {
    { LAS float* T5 = (LAS float*)(F.lds + NW * 16384); LAS float* CR = (LAS float*)(F.lds + NW * 16384 + 1024);
      for (int i = F.tid; i < 256; i += NW * 64) T5[i] = A.in[15][i];
      for (int i = F.tid; i < 257 * 4; i += NW * 64) CR[i] = A.in[14][(size_t)layer * 257 * 4 + i];
      __syncthreads(); }
    LAS float* scr = (LAS float*)(F.lds + RING_OFF + F.wave * 16384);
    const int gw = F.vcu * NW + F.wave, NGW = F.G * NW; const int lane = F.lane;
    for (int u0 = gw; u0 < U_TOTAL; u0 += NGW) {
        int u = u0;
        if (u < U_ATT) {
            int kind, qrow, qcol, h, qpos, nct = 0, cstride = 0, npt, prow0, kcol, vcol, kpos0, zcol, ycol; bool writer = true, has_sink; float sink = 0.f; const float* cK = nullptr; const float* cV = nullptr;
            if (u < U_CP) { h = u & 3; const int n = (u >> 2) & 31, b = u >> 7; const int c0 = n >= 8 ? n - 8 : 0; qrow = b * SEQ + n * 64 + lane;
                kind = 1; qcol = PC_CQ + h * 64; qpos = qrow; npt = 2 * (n + 1 - c0); prow0 = b * SEQ + c0 * 64; kcol = PC_CK + h * 64; vcol = PC_CV + h * 64; kpos0 = prow0; has_sink = false; zcol = PC_CZ + h * 64; ycol = YC_C + h * 64; }
            else if (u < U_CP + U_BP) { u -= U_CP; h = u & 7; const int n = (u >> 3) & 31, b = u >> 8; const int c0 = n >= 2 ? n - 2 : 0; qrow = b * SEQ + n * 64 + lane; const int kvh = h >> 2;
                kind = 0; qcol = PC_BQ + h * 64; qpos = qrow; npt = 2 * (n + 1 - c0); prow0 = b * SEQ + c0 * 64; kcol = PC_BK + kvh * 64; vcol = PC_BV + kvh * 64; kpos0 = prow0; has_sink = true; zcol = PC_BZ + h * 64; ycol = YC_B + h * 64; }
            else if (u < U_CP + U_BP + U_CS) { u -= U_CP + U_BP; h = u & 3; const int s = u >> 2; const int i = lane & 31; qrow = NPROMPT + s * 32 + i;
                cK = A.in[4] + ((size_t)(layer * 32 + s) * 512) * 256 + h * 64; cV = A.in[5] + ((size_t)(layer * 32 + s) * 512) * 256 + h * 64;
                kind = 1; qcol = PC_CQ + h * 64; qpos = i; writer = lane < 32; nct = 16; cstride = 256; npt = 1; prow0 = NPROMPT + s * 32; kcol = PC_CK + h * 64; vcol = PC_CV + h * 64; kpos0 = -512; has_sink = false; zcol = PC_CZ + h * 64; ycol = YC_C + h * 64; }
            else { u -= U_CP + U_BP + U_CS; const int gp = u & 1, kvh = (u >> 1) & 1, s = u >> 2; const int i = lane & 31; h = kvh * 4 + gp * 2 + (lane >> 5); qrow = NPROMPT + s * 32 + i;
                cK = A.in[2] + ((size_t)(layer * 32 + s) * 128) * 128 + kvh * 64; cV = A.in[3] + ((size_t)(layer * 32 + s) * 128) * 128 + kvh * 64;
                kind = 0; qcol = PC_BQ + h * 64; qpos = i; nct = 4; cstride = 128; npt = 1; prow0 = NPROMPT + s * 32; kcol = PC_BK + kvh * 64; vcol = PC_BV + kvh * 64; kpos0 = -128; has_sink = true; zcol = PC_BZ + h * 64; ycol = YC_B + h * 64; }
            if (has_sink) sink = A.in[13][layer * 8 + h];
            attn_simple(F, A, scr, (const LAS float*)(F.lds + NW * 16384), (const LAS float*)(F.lds + NW * 16384 + 1024), lane, kind, qrow, qcol, h, qpos, writer, nct, cK, cV, cstride, npt, prow0, kcol, vcol, kpos0, sink, has_sink, zcol, ycol);
        } else {
            u -= U_ATT;
            int T, row0, g; float* avs = nullptr;
            if (u < U_AP) { g = u & 3; const int n = (u >> 2) & 15, b = u >> 6; T = 128; row0 = b * SEQ + n * 128; }
            else { u -= U_AP; g = u & 3; const int s = u >> 2; T = 32; row0 = NPROMPT + s * 32; avs = F.out + O_AVS + ((size_t)layer * NSAMP + s * 32) * 256; }
            mixa_simple(F, A, scr, lane, layer, T, row0, g, avs);
        }
    }
}

constexpr int N_PHASES = 1 + 4 * DEPTH;
__global__ void __launch_bounds__(NWAVES * 64, 2) mk_fwd(Args args) {
    extern __shared__ __attribute__((aligned(16))) unsigned char lds[];
    Frame F;
    F.lds = (LAS unsigned char*)lds;
    F.MISC = (volatile LAS unsigned*)(F.lds + MISC_OFF);
    F.tid = threadIdx.x; F.lane = F.tid & 63; F.wave = __builtin_amdgcn_readfirstlane(F.tid >> 6);
    F.G = gridDim.x; { const int bx = blockIdx.x; F.vcu = (F.G % 8 == 0) ? (bx % 8) * (F.G / 8) + bx / 8 : bx; }
    unsigned char* ws = args.ws;
    F.ctl = (gu32*)(ws + WS_CTL);
    F.out = args.out;
    F.Win_t = (bf16*)(ws + WS_WIN); F.Wout_t = (bf16*)(ws + WS_WOUT); F.XN = (bf16*)(ws + WS_XN); F.P = (bf16*)(ws + WS_P); F.Y = (bf16*)(ws + WS_Y); F.YF = (float*)(ws + WS_YF);
    for (int u = F.tid; u < (LDS_BYTES - LDSCTL_OFF) / 4; u += NWAVES * 64) ((LAS unsigned*)(F.lds + LDSCTL_OFF))[u] = 0u;
    __syncthreads();
    const int lo = args.ph_lo, hi = args.ph_hi;
    const bool multi = (hi - lo) > 1;
    XcdBarrier bar; bar.bar = (unsigned*)(F.ctl + CW_BAR); bar.x = 0; bar.st = nullptr;
    if (multi) bar = xcd_barrier_post((unsigned*)(F.ctl + CW_BAR), F.MISC + 8);
#define IN(k) (lo <= (k) && (k) < hi)
#define SEAM(k) do { if (IN(k) && IN((k) + 1)) xcd_barrier(bar); } while (0)
    if (IN(0)) { p0_prologue(F, args); SEAM(0); }
    for (int layer = 0; layer < DEPTH; ++layer) {
        const int p0 = 1 + 4 * layer;
        if (IN(p0)) {
            pg8::Gemm g{F.XN, F.Win_t + (size_t)layer * NIN * D, M, NIN, D}; pg8::StaticOrder S; S.init(M, NIN, F.G, (int)blockIdx.x);
            pg8::EpiP E{F.P, F.out, layer};
            pg8::gemm_phase<pg8::EpiP, pg8::StaticOrder, true, true>(F.lds + RING_OFF, g, S, E);
            SEAM(p0);
        }
        if (IN(p0 + 1)) {   SEAM(p0 + 1); }
        if (IN(p0 + 2)) {
            pg8::Gemm g{F.Y, F.Wout_t + (size_t)layer * D * D, M, D, D}; pg8::StaticOrder S; S.init(M, D, F.G, (int)blockIdx.x);
            pg8::EpiF32 E{F.YF, D};
            pg8::gemm_phase<pg8::EpiF32, pg8::StaticOrder, true, true>(F.lds + RING_OFF, g, S, E);
            SEAM(p0 + 2);
        }
        if (IN(p0 + 3)) { post_phase(F, args, layer); SEAM(p0 + 3); }
    }
#undef IN
#undef SEAM
}

constexpr int MIXK_LDS = 4 * 16384 + 1024 + 4352;
__global__ void __launch_bounds__(256) mix_simple_kernel(Args args, int layer) {
    __shared__ __attribute__((aligned(16))) unsigned char lds_m[MIXK_LDS];
    Frame F;
    F.lds = (LAS unsigned char*)lds_m; F.MISC = nullptr; F.ctl = nullptr;
    F.tid = threadIdx.x; F.lane = F.tid & 63; F.wave = __builtin_amdgcn_readfirstlane(F.tid >> 6);
    F.G = gridDim.x; F.vcu = blockIdx.x;
    unsigned char* ws = args.ws; F.out = args.out;
    F.Win_t = nullptr; F.Wout_t = nullptr; F.XN = nullptr; F.P = (bf16*)(ws + WS_P); F.Y = (bf16*)(ws + WS_Y); F.YF = nullptr;
    mix_phase_simple<4>(F, args, layer);
}

#ifndef MK_SINGLE
#define MK_SINGLE 0
#endif
extern "C" void kernel_launch(void* const* d_in, const int* in_sizes, int n_in, void* d_out, int out_size, void* d_ws, size_t ws_size, hipStream_t stream) {
    static int grid = 0;
    if (grid == 0) {
        if (n_in != 16 || out_size != (int)O_END || ws_size < WS_END) { fprintf(stderr, "kernel_launch: unexpected shapes: n_in %d out %d ws %zu\n", n_in, out_size, ws_size); grid = -1; return; }
        int dev = 0, cus = 0;
        if (hipGetDevice(&dev) != hipSuccess || hipDeviceGetAttribute(&cus, hipDeviceAttributeMultiprocessorCount, dev) != hipSuccess) { grid = -1; return; }
        if (hipFuncSetAttribute((const void*)mk_fwd, hipFuncAttributeMaxDynamicSharedMemorySize, LDS_BYTES) != hipSuccess) { fprintf(stderr, "kernel_launch: hipFuncSetAttribute failed\n"); grid = -1; return; }
        (void)hipGetLastError();
        grid = cus;
    }
    if (grid < 0) return;
    (void)hipMemsetAsync((char*)d_ws + WS_CTL, 0, CTL_ZERO_BYTES, stream);
    Args a{};
    for (int i = 0; i < 16; ++i) a.in[i] = (const float*)d_in[i];
    a.out = (float*)d_out; a.ws = (unsigned char*)d_ws;
#if MK_SINGLE
    a.ph_lo = 0; a.ph_hi = N_PHASES;
    hipLaunchKernelGGL(mk_fwd, dim3(grid), dim3(NWAVES * 64), LDS_BYTES, stream, a);
#else
    for (int ph = 0; ph < N_PHASES; ++ph) {
        if (ph >= 1 && ((ph - 1) & 3) == 1) { hipLaunchKernelGGL(mix_simple_kernel, dim3(1024), dim3(256), 0, stream, a, (ph - 1) >> 2); continue; }
        a.ph_lo = ph; a.ph_hi = ph + 1; hipLaunchKernelGGL(mk_fwd, dim3(grid), dim3(NWAVES * 64), LDS_BYTES, stream, a); }
#endif
}
```

```cpp
#include <hip/hip_runtime.h>
#include <cstdio>
#include <cstdint>

constexpr int D = 1024, NPROMPT = 8 * 2048, NSAMP = 32 * 32, M = NPROMPT + NSAMP  , NIN = 3072, DEPTH = 4, SEQ = 2048;
constexpr float RMS_EPS = 1e-6f;
constexpr int PC_AU = 0, PC_AV = 256, PC_AZ = 512, PC_BQ = 768, PC_BK = 1280, PC_BV = 1408, PC_BZ = 1536, PC_CQ = 2048, PC_CK = 2304, PC_CV = 2560, PC_CZ = 2816;
constexpr int YC_A = 0, YC_B = 256, YC_C = 768;
constexpr size_t O_YP = 0, O_YS = 16777216, O_BKP = 17825792, O_BVP = 18350080, O_CKP = 18874368, O_CVP = 23068672, O_BKS = 27262976, O_BVS = 27787264, O_CKS = 28311552, O_CVS = 29360128, O_AVS = 30408704, O_END = 31457280;

namespace pg8 {
#define PG8_LAS __attribute__((address_space(3)))
typedef unsigned short bf16_t;
typedef short bf16x8 __attribute__((ext_vector_type(8)));
typedef float f32x4 __attribute__((ext_vector_type(4)));
typedef unsigned u32x4 __attribute__((ext_vector_type(4)));
constexpr int BM = 256, BK = 64, HALF = 128, HTB = HALF * BK * 2  , STAGE_BYTES = 8 * HTB, NXCD = 8, WGM = 8;

__host__ __device__ __forceinline__ int lds_byte(int r, int c) { const int st = (r >> 4) * 2 + (c >> 5), rr = r & 15, cc = c & 31, ob = rr * 64 + cc * 2; return st * 1024 + (ob ^ (((ob >> 9) & 1) << 5)); }
__host__ __device__ __forceinline__ void stage_rc(int b, int& R, int& C) { const int st = b / 1024, sb = b % 1024, swz = sb ^ (((sb >> 9) & 1) << 5); R = (st >> 1) * 16 + swz / 64; C = (st & 1) * 32 + (swz % 64) / 2; }
__host__ __device__ __forceinline__ int perm32(int rho) { const int n = rho >> 4, i = rho & 15; return 8 * (i >> 2) + 4 * n + (i & 3); }

struct Unit { int pm, pn; };
struct Gemm { const bf16_t* A; const bf16_t* Bt; int M, N, K; };

struct StaticOrder {
    int nM, nN, nwg, G, c;
    __host__ __device__ void init(int M, int N, int G_, int c_) { nM = M / BM; nN = N / BM; nwg = nM * nN; G = G_; c = c_; }
    __host__ __device__ bool next(int i, Unit& u) const {
        const long L = (long)i * G + c; if (L >= nwg) return false;
        int wgid = (int)L; { const int q = nwg / NXCD, r = nwg % NXCD, xcd = wgid % NXCD, off = wgid / NXCD; wgid = (xcd < r ? xcd * (q + 1) : r * (q + 1) + (xcd - r) * q) + off; }
        const int nig = WGM * nN, gid = wgid / nig, fm = gid * WGM, gsz = (nM - fm) < WGM ? (nM - fm) : WGM;
        u.pm = fm + ((wgid % nig) % gsz); u.pn = (wgid % nig) / gsz; return true;
    }
    __device__ __forceinline__ void a_ready(const Unit&) const {}
    __device__ __forceinline__ void done(const Unit&) const {}
};


__device__ __forceinline__ unsigned cvt_pk_bf16(float lo, float hi) { unsigned r; asm volatile("v_cvt_pk_bf16_f32 %0, %1, %2" : "=v"(r) : "v"(lo), "v"(hi)); return r; }

struct EpiP {
    static constexpr bool PERM = true, AFTER_DRAIN = false;
    bf16_t* O; float* out; int layer;
    __device__ __forceinline__ void operator()(const f32x4 (&acc)[2][2][4][2], const Unit& u, int wr, int wc, int fr, int fq) const {
        const int row0 = u.pm * BM + wr * 64 + fr; const int col0 = u.pn * BM + wc * 32 + 8 * fq;
#pragma unroll
        for (int ai = 0; ai < 2; ++ai)
#pragma unroll
            for (int m = 0; m < 4; ++m) { bf16_t* rowp = O + (size_t)(row0 + ai * HALF + m * 16) * NIN + col0;
#pragma unroll
                for (int bj = 0; bj < 2; ++bj) { const f32x4 v0 = acc[ai][bj][m][0], v1 = acc[ai][bj][m][1];
                    u32x4 w; w.x = cvt_pk_bf16(v0[0], v0[1]); w.y = cvt_pk_bf16(v0[2], v0[3]); w.z = cvt_pk_bf16(v1[0], v1[1]); w.w = cvt_pk_bf16(v1[2], v1[3]);
                    *(u32x4*)(rowp + bj * HALF) = w; } }
        if (u.pn == 5 || u.pn == 9 || u.pn == 10) {
            const int cc = wc * 32 + 8 * fq;
#pragma unroll
            for (int ai = 0; ai < 2; ++ai)
#pragma unroll
                for (int m = 0; m < 4; ++m) {
                    const int r = row0 + ai * HALF + m * 16;
                    float* d0 = nullptr; float* d1 = nullptr;
                    if (u.pn == 5) {
                        if (r >= NPROMPT) { const size_t o = ((size_t)layer * NSAMP + (r - NPROMPT)) * 128 + cc; d0 = out + O_BKS + o; d1 = out + O_BVS + o; }
                        else { const int t = r & (SEQ - 1), b = r >> 11; if (t >= SEQ - 128) { const size_t o = (((size_t)layer * 8 + b) * 128 + (t - (SEQ - 128))) * 128 + cc; d0 = out + O_BKP + o; d1 = out + O_BVP + o; } }
                    } else {
                        const size_t os = (u.pn == 9) ? O_CKS : O_CVS, op = (u.pn == 9) ? O_CKP : O_CVP;
                        if (r >= NPROMPT) { const size_t o = ((size_t)layer * NSAMP + (r - NPROMPT)) * 256 + cc; d0 = out + os + o; d1 = d0 + 128; }
                        else { const int t = r & (SEQ - 1), b = r >> 11; if (t >= SEQ - 512) { const size_t o = (((size_t)layer * 8 + b) * 512 + (t - (SEQ - 512))) * 256 + cc; d0 = out + op + o; d1 = d0 + 128; } }
                    }
                    if (d0) { *(f32x4*)(d0) = acc[ai][0][m][0]; *(f32x4*)(d0 + 4) = acc[ai][0][m][1]; *(f32x4*)(d1) = acc[ai][1][m][0]; *(f32x4*)(d1 + 4) = acc[ai][1][m][1]; }
                }
        }
    }
};
struct EpiF32 {
    static constexpr bool PERM = false, AFTER_DRAIN = false;
    float* C; int ldc;
    __device__ __forceinline__ void operator()(const f32x4 (&acc)[2][2][4][2], const Unit& u, int wr, int wc, int fr, int fq) const {
        const int row0 = u.pm * BM + wr * 64 + fr, col0 = u.pn * BM + wc * 32 + 4 * fq;
#pragma unroll
        for (int ai = 0; ai < 2; ++ai)
#pragma unroll
            for (int m = 0; m < 4; ++m) { float* rowp = C + (size_t)(row0 + ai * HALF + m * 16) * ldc + col0;
#pragma unroll
                for (int bj = 0; bj < 2; ++bj)
#pragma unroll
                    for (int n = 0; n < 2; ++n) *(f32x4*)(rowp + bj * HALF + n * 16) = acc[ai][bj][m][n]; }
    }
};

template <class Epi, class Sched, bool ALIGN_EPI = false, bool SP2 = false>
__device__ __forceinline__ void gemm_phase(PG8_LAS unsigned char* lds, const Gemm g, const Sched& S, const Epi& E) {
    int tid_ = threadIdx.x; asm volatile("" : "+v"(tid_));
    const int tid = tid_, wid = __builtin_amdgcn_readfirstlane(tid >> 6), lane = tid & 63, wr = wid >> 2, wc = wid & 3, fr = lane & 15, fq = lane >> 4;
    const int K = g.K, nt = K / BK;
    unsigned voffA[2], voffB[2];
#pragma unroll
    for (int i = 0; i < 2; ++i) { int R, C; stage_rc(tid * 16 + i * 8192, R, C); const int Rb = Epi::PERM ? ((R & ~31) + perm32(R & 31)) : R;
        voffA[i] = (unsigned)(R * K + C) * 2u; voffB[i] = (unsigned)(Rb * K + C) * 2u; }
    const size_t kstep = (size_t)(BK * 2);
    const size_t hstep = (size_t)HALF * K * 2;
    const size_t tstep = 2 * hstep;
    const unsigned ldsw = (unsigned)wid * 1024u;
    const int aoff = lds_byte(wr * 64 + fr, fq * 8), boff = lds_byte(wc * 32 + fr, fq * 8);
#define PG8_SA(b, h) (((b) * 2 + (h)) * HTB)
#define PG8_SB(b, h) ((4 + (b) * 2 + (h)) * HTB)
#define PG8_STAGE(bufoff, gbase, voff) do { _Pragma("unroll") for (int _i = 0; _i < 2; ++_i) \
        __builtin_amdgcn_global_load_lds((const unsigned*)((const char*)(gbase) + (voff)[_i]), (PG8_LAS unsigned*)(lds + (bufoff) + ldsw + _i * 8192), 16, 0, 0); } while (0)
#define PG8_LDA(dst, b, h) do { _Pragma("unroll") for (int m = 0; m < 4; ++m) _Pragma("unroll") for (int k = 0; k < 2; ++k) dst[m][k] = *(const PG8_LAS bf16x8*)(lds + PG8_SA(b, h) + aoff + m * 2048 + k * 1024); } while (0)
#define PG8_LDB(dst, b, h) do { _Pragma("unroll") for (int n = 0; n < 2; ++n) _Pragma("unroll") for (int k = 0; k < 2; ++k) dst[n][k] = *(const PG8_LAS bf16x8*)(lds + PG8_SB(b, h) + boff + n * 2048 + k * 1024); } while (0)
#define PG8_MMA(ai, bj, At, Bt) do { __builtin_amdgcn_s_setprio(1); _Pragma("unroll") for (int m = 0; m < 4; ++m) _Pragma("unroll") for (int n = 0; n < 2; ++n) _Pragma("unroll") for (int k = 0; k < 2; ++k) \
        acc[ai][bj][m][n] = __builtin_amdgcn_mfma_f32_16x16x32_bf16(Bt[n][k], At[m][k], acc[ai][bj][m][n], 0, 0, 0); __builtin_amdgcn_s_setprio(0); } while (0)
#define PG8_WAIT_V(n) asm volatile("s_waitcnt vmcnt(" #n ")" ::: "memory")
#define PG8_WAIT_L(n) asm volatile("s_waitcnt lgkmcnt(" #n ")" ::: "memory")
#define PG8_BAR __builtin_amdgcn_s_barrier()
#define PG8_SCHED __builtin_amdgcn_sched_barrier(0)
    Unit cur, nxt; int ui = 0;
    if (!S.next(0, cur)) return;
    f32x4 acc[2][2][4][2];
#pragma unroll
    for (int a = 0; a < 2; ++a)
#pragma unroll
        for (int b = 0; b < 2; ++b)
#pragma unroll
            for (int m = 0; m < 4; ++m)
#pragma unroll
                for (int n = 0; n < 2; ++n) acc[a][b][m][n] = (f32x4){0.f, 0.f, 0.f, 0.f};
    bf16x8 At[4][2], B0[2][2], B1[2][2];
    const char* cA = (const char*)g.A + (size_t)cur.pm * tstep; const char* cB = (const char*)g.Bt + (size_t)cur.pn * tstep;
    S.a_ready(cur);
    if constexpr (SP2) {
        PG8_STAGE(PG8_SB(0, 0), cB, voffB); PG8_STAGE(PG8_SB(0, 1), cB + hstep, voffB); PG8_STAGE(PG8_SA(0, 0), cA, voffA); PG8_STAGE(PG8_SA(0, 1), cA + hstep, voffA);
        if (wr == 1) PG8_BAR;
        PG8_WAIT_V(2); PG8_BAR;
        PG8_STAGE(PG8_SB(1, 0), cB + kstep, voffB); PG8_STAGE(PG8_SA(1, 0), cA + kstep, voffA); PG8_STAGE(PG8_SB(1, 1), cB + hstep + kstep, voffB);
        PG8_WAIT_V(6); PG8_BAR;
    } else {
        PG8_STAGE(PG8_SB(0, 0), cB, voffB); PG8_STAGE(PG8_SA(0, 0), cA, voffA); PG8_STAGE(PG8_SB(0, 1), cB + hstep, voffB); PG8_STAGE(PG8_SA(0, 1), cA + hstep, voffA);
        if (wr == 1) PG8_BAR;
        PG8_WAIT_V(4); PG8_BAR;
        PG8_STAGE(PG8_SB(1, 0), cB + kstep, voffB); PG8_STAGE(PG8_SA(1, 0), cA + kstep, voffA); PG8_STAGE(PG8_SB(1, 1), cB + hstep + kstep, voffB);
        PG8_WAIT_V(6); PG8_BAR;
    }
    for (;;) {
        const bool has_next = S.next(ui + 1, nxt);
        const char* nA = has_next ? (const char*)g.A + (size_t)nxt.pm * tstep : cA; const char* nB = has_next ? (const char*)g.Bt + (size_t)nxt.pn * tstep : cB;
        for (int t = 0; t < nt; t += 2) {
            const bool last = (t == nt - 2);
            const char* a1 = cA + (size_t)(t + 1) * kstep;
            const char* a2 = last ? nA : cA + (size_t)(t + 2) * kstep; const char* b2 = last ? nB : cB + (size_t)(t + 2) * kstep;
            const char* a3 = a2 + kstep; const char* b3 = b2 + kstep;
            if (last && has_next) S.a_ready(nxt);
            if constexpr (SP2) {
            PG8_LDB(B0, 0, 0); PG8_LDB(B1, 0, 1); PG8_SCHED; PG8_LDA(At, 0, 0); PG8_STAGE(PG8_SA(1, 1), a1 + hstep, voffA);
            PG8_WAIT_V(8); PG8_WAIT_L(0); PG8_BAR; PG8_MMA(0, 0, At, B0); PG8_MMA(0, 1, At, B1); PG8_BAR; PG8_SCHED;
            PG8_LDA(At, 0, 1); PG8_STAGE(PG8_SB(0, 0), b2, voffB); PG8_STAGE(PG8_SB(0, 1), b2 + hstep, voffB); PG8_STAGE(PG8_SA(0, 0), a2, voffA);
            PG8_WAIT_V(8); PG8_WAIT_L(0); PG8_BAR; PG8_MMA(1, 0, At, B0); PG8_MMA(1, 1, At, B1); PG8_BAR; PG8_SCHED;
            PG8_LDB(B0, 1, 0); PG8_LDB(B1, 1, 1); PG8_SCHED; PG8_LDA(At, 1, 0); PG8_STAGE(PG8_SA(0, 1), a2 + hstep, voffA);
            PG8_WAIT_V(8); PG8_WAIT_L(0); PG8_BAR; PG8_MMA(0, 0, At, B0); PG8_MMA(0, 1, At, B1); PG8_BAR; PG8_SCHED;
            PG8_LDA(At, 1, 1); PG8_STAGE(PG8_SB(1, 0), b3, voffB); PG8_STAGE(PG8_SB(1, 1), b3 + hstep, voffB); PG8_STAGE(PG8_SA(1, 0), a3, voffA);
            PG8_WAIT_V(8); PG8_WAIT_L(0); PG8_BAR; PG8_MMA(1, 0, At, B0); PG8_MMA(1, 1, At, B1); PG8_BAR; PG8_SCHED;
            } else {
            PG8_LDB(B0, 0, 0); PG8_SCHED; PG8_LDA(At, 0, 0); PG8_STAGE(PG8_SA(1, 1), a1 + hstep, voffA);
            PG8_WAIT_L(8); PG8_BAR; PG8_WAIT_L(0); PG8_MMA(0, 0, At, B0); PG8_BAR; PG8_SCHED;
            PG8_LDB(B1, 0, 1); PG8_STAGE(PG8_SB(0, 0), b2, voffB);
            PG8_BAR; PG8_WAIT_L(0); PG8_MMA(0, 1, At, B1); PG8_BAR;
            PG8_LDA(At, 0, 1); PG8_STAGE(PG8_SA(0, 0), a2, voffA);
            PG8_BAR; PG8_WAIT_L(0); PG8_MMA(1, 0, At, B0); PG8_BAR; PG8_SCHED;
            PG8_STAGE(PG8_SB(0, 1), b2 + hstep, voffB);
            PG8_WAIT_V(6); PG8_BAR; PG8_MMA(1, 1, At, B1); PG8_BAR;
            PG8_LDB(B0, 1, 0); PG8_SCHED; PG8_LDA(At, 1, 0); PG8_STAGE(PG8_SA(0, 1), a2 + hstep, voffA);
            PG8_WAIT_L(8); PG8_BAR; PG8_WAIT_L(0); PG8_MMA(0, 0, At, B0); PG8_BAR; PG8_SCHED;
            PG8_LDB(B1, 1, 1); PG8_STAGE(PG8_SB(1, 0), b3, voffB);
            PG8_BAR; PG8_WAIT_L(0); PG8_MMA(0, 1, At, B1); PG8_BAR;
            PG8_LDA(At, 1, 1); PG8_STAGE(PG8_SA(1, 0), a3, voffA);
            PG8_BAR; PG8_WAIT_L(0); PG8_MMA(1, 0, At, B0); PG8_BAR; PG8_SCHED;
            PG8_STAGE(PG8_SB(1, 1), b3 + hstep, voffB);
            PG8_WAIT_V(6); PG8_BAR; PG8_MMA(1, 1, At, B1); PG8_BAR;
            }
        }
        if constexpr (ALIGN_EPI) { if (wr == 0) PG8_BAR; }
        if constexpr (!Epi::AFTER_DRAIN) { E(acc, cur, wr, wc, fr, fq); S.done(cur); }
        if (!has_next) break;
#pragma unroll
        for (int a = 0; a < 2; ++a)
#pragma unroll
            for (int b = 0; b < 2; ++b)
#pragma unroll
                for (int m = 0; m < 4; ++m)
#pragma unroll
                    for (int n = 0; n < 2; ++n) acc[a][b][m][n] = (f32x4){0.f, 0.f, 0.f, 0.f};
        cur = nxt; cA = nA; cB = nB; ++ui;
        if constexpr (ALIGN_EPI) { if (wr == 1) PG8_BAR; }
    }
    PG8_WAIT_V(0);
    if constexpr (!ALIGN_EPI) { if (wr == 0) PG8_BAR; }
    PG8_BAR;
    if constexpr (Epi::AFTER_DRAIN) { E.fused(acc, cur, wr, wc, fr, fq, lds, wid, lane); S.done(cur); }
#undef PG8_SA
#undef PG8_SB
#undef PG8_STAGE
#undef PG8_LDA
#undef PG8_LDB
#undef PG8_MMA
#undef PG8_WAIT_V
#undef PG8_WAIT_L
#undef PG8_BAR
#undef PG8_SCHED
}
}
#define GAS __attribute__((address_space(1)))
#define LAS __attribute__((address_space(3)))
typedef unsigned short bf16;
typedef unsigned v4u __attribute__((ext_vector_type(4)));
typedef float f32x4 __attribute__((ext_vector_type(4)));
typedef short bf16x8 __attribute__((ext_vector_type(8)));
typedef GAS unsigned gu32;
typedef GAS unsigned long long gu64;
#define RLX_AGENT __ATOMIC_RELAXED, __HIP_MEMORY_SCOPE_AGENT
#define LDS_WAIT() asm volatile("s_waitcnt lgkmcnt(0)" ::: "memory")
#define VM_WAIT() asm volatile("s_waitcnt vmcnt(0)" ::: "memory")
__device__ __forceinline__ unsigned long long rt() { return __builtin_amdgcn_s_memrealtime(); }
__device__ __forceinline__ unsigned f2bf(float f) { unsigned u = __builtin_bit_cast(unsigned, f); return (u + 0x7fffu + ((u >> 16) & 1u)) >> 16; }
__device__ __forceinline__ unsigned pk2(float lo, float hi) { return f2bf(lo) | (f2bf(hi) << 16); }

#define XB_TMO      128
#define XB_XCNT(j)  (256  + 64 * (j))
#define XB_XSUB(j)  (1280 + 64 * (j))
#define XB_XGEN(j)  (2304 + 64 * (j))
#define XB_TOP      3328
#define XB_TOPGEN   3392
#define XCD_BAR_WORDS 3456
#define XB_SPIN_CAP (1u << 18)

__device__ __forceinline__ unsigned xb_ld(unsigned* p)              { return __hip_atomic_load(p, __ATOMIC_RELAXED, __HIP_MEMORY_SCOPE_AGENT); }
__device__ __forceinline__ unsigned xb_add(unsigned* p, unsigned v) { return __hip_atomic_fetch_add(p, v, __ATOMIC_RELAXED, __HIP_MEMORY_SCOPE_AGENT); }
__device__ __forceinline__ unsigned xb_xcc_id() { return (unsigned)__builtin_amdgcn_s_getreg((3 << 11) | 20) & 0xFu; }
#define XB_SPIN(cond, bar) do { unsigned _sp = 0; while (cond) { __builtin_amdgcn_s_sleep(1); \
    if ((++_sp & 255u) == 0u) { if (xb_ld(&(bar)[XB_TMO])) break; if (_sp > XB_SPIN_CAP) { atomicAdd(&(bar)[XB_TMO], 1u); break; } } } } while (0)

struct XcdBarrier {
    unsigned* bar; unsigned x;
    volatile LAS unsigned* st;
};

__device__ __forceinline__ XcdBarrier xcd_barrier_post(unsigned* bar, volatile LAS unsigned* st) {
    XcdBarrier b; b.bar = bar; b.x = xb_xcc_id(); b.st = st;
    if (threadIdx.x == 0) (void)xb_add(&bar[XB_XCNT(b.x)], 1u);
    return b;
}
__device__ __forceinline__ void xcd_barrier_complete(unsigned* bar, unsigned x, unsigned& nloc, unsigned& nx) {
    const unsigned G = gridDim.x * gridDim.y * gridDim.z;
    unsigned sum, cnt, mine, sp = 0u;
    for (;;) {
        sum = 0u; cnt = 0u; mine = 0u;
#pragma unroll
        for (unsigned j = 0; j < 16; ++j) { const unsigned c = xb_ld(&bar[XB_XCNT(j)]); sum += c; cnt += (c > 0u) ? 1u : 0u; mine = (j == x) ? c : mine; }
        if (sum == G) break;
        __builtin_amdgcn_s_sleep(1);
        if ((++sp & 255u) == 0u) { if (xb_ld(&bar[XB_TMO])) break; if (sp > XB_SPIN_CAP) { atomicAdd(&bar[XB_TMO], 1u); break; } }
    }
    nloc = mine > 0u ? mine : 1u; nx = cnt > 0u ? cnt : 1u;
}

__device__ __forceinline__ void xcd_barrier(const XcdBarrier& b) {
    asm volatile("s_waitcnt vmcnt(0)" ::: "memory");
    __syncthreads();
    if (threadIdx.x == 0) {
        unsigned* bar = b.bar;
        __builtin_amdgcn_s_waitcnt(0);
        unsigned nloc = b.st[0], nx = b.st[1];
        if (nloc == 0u) { xcd_barrier_complete(bar, b.x, nloc, nx); b.st[0] = nloc; b.st[1] = nx; }
        const unsigned old = xb_add(&bar[XB_XSUB(b.x)], 1u);
        const unsigned gen = old / nloc;
        if (old + 1u == (gen + 1u) * nloc) {
            __builtin_amdgcn_fence(__ATOMIC_RELEASE, "agent");
            asm volatile("s_waitcnt vmcnt(0)" ::: "memory");
            const unsigned og = xb_add(&bar[XB_TOP], 1u);
            const unsigned tg = og / nx;
            if (og + 1u == (tg + 1u) * nx) xb_add(&bar[XB_TOPGEN], 1u);
            else XB_SPIN(xb_ld(&bar[XB_TOPGEN]) == tg, bar);
            __builtin_amdgcn_fence(__ATOMIC_ACQUIRE, "agent");
            xb_add(&bar[XB_XGEN(b.x)], 1u);
            asm volatile("s_waitcnt vmcnt(0)" ::: "memory");
        } else {
            XB_SPIN(xb_ld(&bar[XB_XGEN(b.x)]) == gen, bar);
            __builtin_amdgcn_fence(__ATOMIC_ACQUIRE, "agent");
            asm volatile("s_waitcnt vmcnt(0)" ::: "memory");
        }
    }
    __syncthreads();
}

constexpr size_t MiB = 1u << 20;
constexpr size_t WS_CTL = 0, CTL_ZERO_BYTES = 1 * MiB;
constexpr size_t WS_WIN = 2 * MiB;
constexpr size_t WS_WOUT = 26 * MiB;
constexpr size_t WS_XN = 34 * MiB;
constexpr size_t WS_P = 68 * MiB;
constexpr size_t WS_Y = 170 * MiB;
constexpr size_t WS_YF = WS_P;
constexpr size_t WS_WTRIL = 204 * MiB;
constexpr size_t WS_END = 205 * MiB;
constexpr int CW_BAR = 4096;

constexpr int RING_OFF = 0, RING_BYTES = 131072;
constexpr int KV_OFF = 0;
constexpr int TABB_OFF = 65536, TABC_OFF = TABB_OFF + 8 * 2 * 264 * 4, WSF_OFF = TABC_OFF + 4 * 2 * 264 * 4;
static_assert(WSF_OFF + 8 * 64 * 4 <= RING_BYTES, "MIX LDS map");
constexpr int LDSCTL_OFF = RING_BYTES, MISC_OFF = LDSCTL_OFF + 320;
constexpr int LDS_BYTES = 147456;
static_assert(MISC_OFF + 128 <= LDS_BYTES, "LDS map");
constexpr int NWAVES = 8;

struct Args { const float* in[16]; float* out; unsigned char* ws; int ph_lo, ph_hi; };
struct Frame {
    LAS unsigned char* lds;
    unsigned char* ws;
    int tid, lane, wave;
    int vcu, G;
    float* out;
    __device__ __forceinline__ bf16* Win_t() const { return (bf16*)(ws + WS_WIN); }
    __device__ __forceinline__ bf16* Wout_t() const { return (bf16*)(ws + WS_WOUT); }
    __device__ __forceinline__ bf16* XN() const { return (bf16*)(ws + WS_XN); }
    __device__ __forceinline__ bf16* P() const { return (bf16*)(ws + WS_P); }
    __device__ __forceinline__ bf16* Y() const { return (bf16*)(ws + WS_Y); }
    __device__ __forceinline__ bf16* Wtril() const { return (bf16*)(ws + WS_WTRIL); }
    __device__ __forceinline__ float* YF() const { return (float*)(ws + WS_YF); }
};

__device__ __forceinline__ float bf2f(bf16 v) { return __builtin_bit_cast(float, (unsigned)v << 16); }
__device__ __forceinline__ float wave_sum(float v) {
#pragma unroll
    for (int o = 1; o < 64; o <<= 1) v += __shfl_xor(v, o);
    return v;
}
__device__ __forceinline__ void p0_transpose_item(const float* W, int K, int N, bf16* WT, LAS float* scr, int item, int lane) {
    const int nblk = N / 32, kb = item / nblk, nb = item % nblk, k0 = 64 * kb, n0 = 32 * nb;
#pragma unroll 8
    for (int i = 0; i < 32; ++i) { const int kk = 2 * i + (lane >> 5); scr[kk * 33 + (lane & 31)] = W[(size_t)(k0 + kk) * N + n0 + (lane & 31)]; }
    LDS_WAIT(); asm volatile("" ::: "memory");
    const int c = lane & 7;
#pragma unroll
    for (int j = 0; j < 4; ++j) { const int n = (lane >> 3) + 8 * j; const LAS float* s = scr + (8 * c) * 33 + n;
        v4u o; o.x = pk2(s[0 * 33], s[1 * 33]); o.y = pk2(s[2 * 33], s[3 * 33]); o.z = pk2(s[4 * 33], s[5 * 33]); o.w = pk2(s[6 * 33], s[7 * 33]);
        *(GAS v4u*)(WT + (size_t)(n0 + n) * K + k0 + 8 * c) = o; }
    LDS_WAIT(); asm volatile("" ::: "memory");
}
__device__ __forceinline__ void rms_row_to_bf16(int lane, const float* xrow, const float* g, bf16* orow) {
    const GAS f32x4* xr = (const GAS f32x4*)xrow + lane; const GAS f32x4* gr = (const GAS f32x4*)g + lane;
    f32x4 v[4]; float s = 0.f;
#pragma unroll
    for (int j = 0; j < 4; ++j) { v[j] = xr[64 * j]; s += (v[j].x * v[j].x + v[j].y * v[j].y) + (v[j].z * v[j].z + v[j].w * v[j].w); }
    const float rstd = 1.f / sqrtf(wave_sum(s) * (1.f / D) + RMS_EPS);
    GAS unsigned long long* o8 = (GAS unsigned long long*)orow + lane;
#pragma unroll
    for (int j = 0; j < 4; ++j) { const f32x4 gg = gr[64 * j];
        o8[64 * j] = (unsigned long long)pk2(v[j].x * rstd * gg.x, v[j].y * rstd * gg.y) | ((unsigned long long)pk2(v[j].z * rstd * gg.z, v[j].w * rstd * gg.w) << 32); }
}
__device__ __forceinline__ const float* x_in_row(const Args& A, int m) { return m < NPROMPT ? A.in[0] + (size_t)m * D : A.in[1] + (size_t)(m - NPROMPT) * D; }

__device__ __forceinline__ void p0_prologue(Frame& F0, const Args& A) {
    Frame F = F0;
    { int tid = threadIdx.x; asm volatile("" : "+v"(tid)); F.tid = tid; F.lane = tid & 63; F.wave = __builtin_amdgcn_readfirstlane(tid >> 6); }
    LAS float* scr = (LAS float*)(F.lds + RING_OFF + F.wave * 16384);
    const int gw = F.vcu * NWAVES + F.wave, NGW = F.G * NWAVES;
    constexpr int I_IN = (D / 64) * (NIN / 32), I_OUT = (D / 64) * (D / 32);
    constexpr int NITEMS = DEPTH * (I_IN + I_OUT);
    for (int it = gw; it < NITEMS; it += NGW) {
        const int l = it / (I_IN + I_OUT); int r = it % (I_IN + I_OUT);
        if (r < I_IN) p0_transpose_item(A.in[8] + (size_t)l * D * NIN, D, NIN, F.Win_t() + (size_t)l * NIN * D, scr, r, F.lane);
        else p0_transpose_item(A.in[9] + (size_t)l * D * D, D, D, F.Wout_t() + (size_t)l * D * D, scr, r - I_IN, F.lane);
    }
    for (int m = gw; m < M; m += NGW) rms_row_to_bf16(F.lane, x_in_row(A, m), A.in[6], F.XN() + (size_t)m * D);
    for (int i = (F.vcu * NWAVES * 64 + F.tid) * 8; i < DEPTH * 4 * 128 * 128; i += F.G * NWAVES * 64 * 8) {
        const int s0 = i & 127, t = (i >> 7) & 127; const float* wp = A.in[11] + i;
        const f32x4 x = *(const GAS f32x4*)wp, y = *(const GAS f32x4*)(wp + 4);
        v4u o; o.x = pk2(s0 + 0 <= t ? x.x : 0.f, s0 + 1 <= t ? x.y : 0.f); o.y = pk2(s0 + 2 <= t ? x.z : 0.f, s0 + 3 <= t ? x.w : 0.f);
        o.z = pk2(s0 + 4 <= t ? y.x : 0.f, s0 + 5 <= t ? y.y : 0.f); o.w = pk2(s0 + 6 <= t ? y.z : 0.f, s0 + 7 <= t ? y.w : 0.f);
        *(GAS v4u*)(F.Wtril() + i) = o; }
}

__device__ __forceinline__ void post_phase(Frame& F0, const Args& A, int layer) {
    Frame F = F0;
    { int tid = threadIdx.x; asm volatile("" : "+v"(tid)); F.tid = tid; F.lane = tid & 63; F.wave = __builtin_amdgcn_readfirstlane(tid >> 6); }
    const int gw = F.vcu * NWAVES + F.wave, NGW = F.G * NWAVES; const int lane = F.lane;
    const GAS f32x4* gp = (const GAS f32x4*)(A.in[7] + (size_t)layer * D) + lane;
    const GAS f32x4* gn = (const GAS f32x4*)(A.in[6] + (size_t)(layer + 1 < DEPTH ? layer + 1 : 0) * D) + lane;
    for (int m = gw; m < M; m += NGW) {
        const GAS f32x4* yr = (const GAS f32x4*)(F.YF() + (size_t)m * D) + lane;
        const GAS f32x4* xr = (const GAS f32x4*)(layer == 0 ? x_in_row(A, m) : F.out + (size_t)m * D) + lane;
        GAS f32x4* xo = (GAS f32x4*)(F.out + (size_t)m * D) + lane;
        f32x4 y[4], x[4]; float s = 0.f;
#pragma unroll
        for (int j = 0; j < 4; ++j) { y[j] = yr[64 * j]; x[j] = xr[64 * j]; s += (y[j].x * y[j].x + y[j].y * y[j].y) + (y[j].z * y[j].z + y[j].w * y[j].w); }
        const float rstd = 1.f / sqrtf(wave_sum(s) * (1.f / D) + RMS_EPS); float s2 = 0.f;
#pragma unroll
        for (int j = 0; j < 4; ++j) { const f32x4 g = gp[64 * j]; x[j] = x[j] + y[j] * rstd * g; xo[64 * j] = x[j]; s2 += (x[j].x * x[j].x + x[j].y * x[j].y) + (x[j].z * x[j].z + x[j].w * x[j].w); }
        if (layer + 1 < DEPTH) {
            const float r2 = 1.f / sqrtf(wave_sum(s2) * (1.f / D) + RMS_EPS);
            GAS unsigned long long* o8 = (GAS unsigned long long*)(F.XN() + (size_t)m * D) + lane;
#pragma unroll
            for (int j = 0; j < 4; ++j) { const f32x4 g = gn[64 * j];
                o8[64 * j] = (unsigned long long)pk2(x[j].x * r2 * g.x, x[j].y * r2 * g.y) | ((unsigned long long)pk2(x[j].z * r2 * g.z, x[j].w * r2 * g.w) << 32); }
        }
    }
}

__device__ __forceinline__ float silu_f(float z) { return z / (1.f + __expf(-z)); }
__device__ __forceinline__ int t5_bucket(int rel) {
    const int n = rel < 0 ? -rel : rel;
    const int lg = 8 + (n >= 12) + (n >= 16) + (n >= 23) + (n >= 32) + (n >= 46) + (n >= 64) + (n >= 91);
    return (rel > 0 ? 16 : 0) + (n < 8 ? n : lg);
}
__device__ __forceinline__ void attn_simple(Frame& F, const Args& A, LAS float* scr, const LAS float* T5, const LAS float* CR, int lane, int KIND,
        int qrow, int qcol, int h, int qpos, bool writer,
        int nct, const float* cK, const float* cV, int cstride,
        int npt, int prow0, int kcol, int vcol,
        int kpos0,
        float sink, bool has_sink, int zcol, int ycol) {
    LAS float* Kl = scr; LAS float* Vl = scr + 2048;
    float q[64], o[64];
    { const bf16* qp = F.P() + (size_t)qrow * NIN + qcol;
#pragma unroll
      for (int d8 = 0; d8 < 8; ++d8) { const v4u w = *(const GAS v4u*)(qp + 8 * d8);
          q[8 * d8 + 0] = __builtin_bit_cast(float, w.x << 16) * 0.125f; q[8 * d8 + 1] = __builtin_bit_cast(float, w.x & 0xffff0000u) * 0.125f;
          q[8 * d8 + 2] = __builtin_bit_cast(float, w.y << 16) * 0.125f; q[8 * d8 + 3] = __builtin_bit_cast(float, w.y & 0xffff0000u) * 0.125f;
          q[8 * d8 + 4] = __builtin_bit_cast(float, w.z << 16) * 0.125f; q[8 * d8 + 5] = __builtin_bit_cast(float, w.z & 0xffff0000u) * 0.125f;
          q[8 * d8 + 6] = __builtin_bit_cast(float, w.w << 16) * 0.125f; q[8 * d8 + 7] = __builtin_bit_cast(float, w.w & 0xffff0000u) * 0.125f; } }
#pragma unroll
    for (int d = 0; d < 64; ++d) o[d] = 0.f;
    float mrun = has_sink ? sink : -1e30f, lrun = has_sink ? 1.f : 0.f;
    const int nt = nct + npt;
    for (int t = 0; t < nt; ++t) {
        asm volatile("s_waitcnt lgkmcnt(0)" ::: "memory");
        if (t < nct) { const float* kp = cK + (size_t)(t * 32) * cstride + lane; const float* vp = cV + (size_t)(t * 32) * cstride + lane;
#pragma unroll 4
            for (int e = 0; e < 32; ++e) { Kl[e * 64 + lane] = kp[(size_t)e * cstride]; Vl[e * 64 + lane] = vp[(size_t)e * cstride]; }
        } else { const bf16* kp = F.P() + (size_t)(prow0 + (t - nct) * 32) * NIN + lane;
#pragma unroll 4
            for (int e = 0; e < 32; ++e) { Kl[e * 64 + lane] = bf2f(kp[(size_t)e * NIN + kcol]); Vl[e * 64 + lane] = bf2f(kp[(size_t)e * NIN + vcol]); }
        }
        asm volatile("s_waitcnt vmcnt(0) lgkmcnt(0)" ::: "memory");
        const int relb = kpos0 + t * 32 - qpos;
#pragma unroll 1
        for (int jj = 0; jj < 32; ++jj) {
            const LAS f32x4* k4 = (const LAS f32x4*)(Kl + jj * 64);
            float s0 = 0.f, s1 = 0.f;
#pragma unroll
            for (int d4 = 0; d4 < 16; d4 += 2) { const f32x4 a = k4[d4], b = k4[d4 + 1];
                s0 += q[4 * d4] * a.x + q[4 * d4 + 1] * a.y + q[4 * d4 + 2] * a.z + q[4 * d4 + 3] * a.w;
                s1 += q[4 * d4 + 4] * b.x + q[4 * d4 + 5] * b.y + q[4 * d4 + 6] * b.z + q[4 * d4 + 7] * b.w;
                if ((d4 & 3) == 2) asm volatile("" ::: "memory"); }
            const int rel = relb + jj;
            float bias;
            if (KIND == 0) bias = T5[t5_bucket(rel) * 8 + h];
            else { const int ci = (rel < -128 ? -128 : (rel > 128 ? 128 : rel)) + 128; bias = CR[ci * 4 + h]; }
            const float s = s0 + s1 + bias;
            if (s > mrun) { const float sc = __expf(mrun - s); lrun *= sc;
#pragma unroll
                for (int d = 0; d < 64; ++d) o[d] *= sc;
                mrun = s; }
            const float p = __expf(s - mrun); lrun += p;
            const LAS f32x4* v4 = (const LAS f32x4*)(Vl + jj * 64);
#pragma unroll
            for (int d4 = 0; d4 < 16; ++d4) { const f32x4 a = v4[d4]; o[4 * d4] += p * a.x; o[4 * d4 + 1] += p * a.y; o[4 * d4 + 2] += p * a.z; o[4 * d4 + 3] += p * a.w;
                if ((d4 & 3) == 3) asm volatile("" ::: "memory"); }
        }
    }
    const float inv = 1.f / lrun;
    if (writer) { const bf16* zp = F.P() + (size_t)qrow * NIN + zcol; bf16* yp = F.Y() + (size_t)qrow * D + ycol;
#pragma unroll
        for (int d8 = 0; d8 < 8; ++d8) { const v4u w = *(const GAS v4u*)(zp + 8 * d8); float z[8];
            z[0] = __builtin_bit_cast(float, w.x << 16); z[1] = __builtin_bit_cast(float, w.x & 0xffff0000u); z[2] = __builtin_bit_cast(float, w.y << 16); z[3] = __builtin_bit_cast(float, w.y & 0xffff0000u);
            z[4] = __builtin_bit_cast(float, w.z << 16); z[5] = __builtin_bit_cast(float, w.z & 0xffff0000u); z[6] = __builtin_bit_cast(float, w.w << 16); z[7] = __builtin_bit_cast(float, w.w & 0xffff0000u);
            v4u r; r.x = pk2(o[8 * d8] * inv * silu_f(z[0]), o[8 * d8 + 1] * inv * silu_f(z[1])); r.y = pk2(o[8 * d8 + 2] * inv * silu_f(z[2]), o[8 * d8 + 3] * inv * silu_f(z[3]));
            r.z = pk2(o[8 * d8 + 4] * inv * silu_f(z[4]), o[8 * d8 + 5] * inv * silu_f(z[5])); r.w = pk2(o[8 * d8 + 6] * inv * silu_f(z[6]), o[8 * d8 + 7] * inv * silu_f(z[7]));
            *(GAS v4u*)(yp + 8 * d8) = r; } }
}

__device__ __forceinline__ void mixa_simple(Frame& F, const Args& A, LAS float* scr, int lane, int layer, int T, int row0, int g, float* avs_out  ) {
    constexpr int TM = 128;
    LAS float* rs = scr;
    LAS float* wr = scr + 128;
    const int c = g * 64 + lane;
    for (int s = 0; s < T; ++s) {
        const unsigned long long w = *(const GAS unsigned long long*)(F.P() + (size_t)(row0 + s) * NIN + PC_AV + 4 * lane);
        const float a = __builtin_bit_cast(float, (unsigned)w << 16), b = __builtin_bit_cast(float, (unsigned)w & 0xffff0000u), cc = __builtin_bit_cast(float, (unsigned)(w >> 32) << 16), dd = __builtin_bit_cast(float, (unsigned)(w >> 32) & 0xffff0000u);
        const float ss = wave_sum((a * a + b * b) + (cc * cc + dd * dd));
        if (lane == 0) rs[s] = 1.f / sqrtf(ss * (1.f / 256.f) + RMS_EPS);
    }
    asm volatile("s_waitcnt lgkmcnt(0)" ::: "memory");
    const float ga = A.in[10][(size_t)layer * 256 + c];
    float vn[TM];
    { const bf16* vp = F.P() + (size_t)row0 * NIN + PC_AV + c;
#pragma unroll
      for (int s8 = 0; s8 < TM; s8 += 8) {
          if (s8 < T) {
#pragma unroll
              for (int s = s8; s < s8 + 8; ++s) vn[s] = bf2f(vp[(size_t)(s - s8) * NIN]) * rs[s] * ga;
              if (avs_out) {
#pragma unroll
                  for (int s = s8; s < s8 + 8; ++s) avs_out[(size_t)s * 256 + c] = vn[s];
              }
          } else {
#pragma unroll
              for (int s = s8; s < s8 + 8; ++s) vn[s] = 0.f;
          }
          vp += 8 * NIN; asm volatile("" : "+v"(vp) :: "memory"); } }
    const float* Wg = A.in[11] + ((size_t)layer * 4 + g) * 128 * 128; const float* bsg = A.in[12] + ((size_t)layer * 4 + g) * 128;
    for (int t = 0; t < T; ++t) {
        asm volatile("s_waitcnt lgkmcnt(0)" ::: "memory");
        for (int s = lane; s < TM; s += 64) wr[s] = (s <= t) ? Wg[(size_t)t * 128 + s] : 0.f;
        asm volatile("s_waitcnt vmcnt(0) lgkmcnt(0)" ::: "memory");
        float a0 = bsg[t], a1 = 0.f;
        const LAS f32x4* w4 = (const LAS f32x4*)wr;
#pragma unroll
        for (int s4 = 0; s4 < TM / 4; s4 += 2) { const f32x4 a = w4[s4], b = w4[s4 + 1];
            a0 += a.x * vn[4 * s4] + a.y * vn[4 * s4 + 1] + a.z * vn[4 * s4 + 2] + a.w * vn[4 * s4 + 3];
            a1 += b.x * vn[4 * s4 + 4] + b.y * vn[4 * s4 + 5] + b.z * vn[4 * s4 + 6] + b.w * vn[4 * s4 + 7];
            if ((s4 & 7) == 6) asm volatile("" ::: "memory"); }
        const bf16* pr = F.P() + (size_t)(row0 + t) * NIN;
        const float y = bf2f(pr[PC_AU + c]) * (a0 + a1) * silu_f(bf2f(pr[PC_AZ + c]));
        F.Y()[(size_t)(row0 + t) * D + YC_A + c] = (bf16)f2bf(y);
    }
}

constexpr int U_AP = 8 * 16 * 4, U_AS = 32 * 4, U_BP = 8 * 32 * 8, U_BS = 32 * 2 * 2, U_CP = 8 * 32 * 4, U_CS = 32 * 4;
constexpr int U_ATT = U_CP + U_BP + U_CS + U_BS, U_TOTAL = U_ATT + U_AP + U_AS;
template <int NW>
__device__ __forceinline__ void mix_phase_simple(Frame& F, const Args& A, int layer) {
    { LAS float* T5 = (LAS float*)(F.lds + NW * 16384); LAS float* CR = (LAS float*)(F.lds + NW * 16384 + 1024);
      for (int i = F.tid; i < 256; i += NW * 64) T5[i] = A.in[15][i];
      for (int i = F.tid; i < 257 * 4; i += NW * 64) CR[i] = A.in[14][(size_t)layer * 257 * 4 + i];
      __syncthreads(); }
    LAS float* scr = (LAS float*)(F.lds + RING_OFF + F.wave * 16384);
    const int gw = F.vcu * NW + F.wave, NGW = F.G * NW; const int lane = F.lane;
    for (int u0 = gw; u0 < U_TOTAL; u0 += NGW) {
        int u = u0;
        if (u < U_ATT) {
            int kind, qrow, qcol, h, qpos, nct = 0, cstride = 0, npt, prow0, kcol, vcol, kpos0, zcol, ycol; bool writer = true, has_sink; float sink = 0.f; const float* cK = nullptr; const float* cV = nullptr;
            if (u < U_CP) { h = u & 3; const int n = (u >> 2) & 31, b = u >> 7; const int c0 = n >= 8 ? n - 8 : 0; qrow = b * SEQ + n * 64 + lane;
                kind = 1; qcol = PC_CQ + h * 64; qpos = qrow; npt = 2 * (n + 1 - c0); prow0 = b * SEQ + c0 * 64; kcol = PC_CK + h * 64; vcol = PC_CV + h * 64; kpos0 = prow0; has_sink = false; zcol = PC_CZ + h * 64; ycol = YC_C + h * 64; }
            else if (u < U_CP + U_BP) { u -= U_CP; h = u & 7; const int n = (u >> 3) & 31, b = u >> 8; const int c0 = n >= 2 ? n - 2 : 0; qrow = b * SEQ + n * 64 + lane; const int kvh = h >> 2;
                kind = 0; qcol = PC_BQ + h * 64; qpos = qrow; npt = 2 * (n + 1 - c0); prow0 = b * SEQ + c0 * 64; kcol = PC_BK + kvh * 64; vcol = PC_BV + kvh * 64; kpos0 = prow0; has_sink = true; zcol = PC_BZ + h * 64; ycol = YC_B + h * 64; }
            else if (u < U_CP + U_BP + U_CS) { u -= U_CP + U_BP; h = u & 3; const int s = u >> 2; const int i = lane & 31; qrow = NPROMPT + s * 32 + i;
                cK = A.in[4] + ((size_t)(layer * 32 + s) * 512) * 256 + h * 64; cV = A.in[5] + ((size_t)(layer * 32 + s) * 512) * 256 + h * 64;
                kind = 1; qcol = PC_CQ + h * 64; qpos = i; writer = lane < 32; nct = 16; cstride = 256; npt = 1; prow0 = NPROMPT + s * 32; kcol = PC_CK + h * 64; vcol = PC_CV + h * 64; kpos0 = -512; has_sink = false; zcol = PC_CZ + h * 64; ycol = YC_C + h * 64; }
            else { u -= U_CP + U_BP + U_CS; const int gp = u & 1, kvh = (u >> 1) & 1, s = u >> 2; const int i = lane & 31; h = kvh * 4 + gp * 2 + (lane >> 5); qrow = NPROMPT + s * 32 + i;
                cK = A.in[2] + ((size_t)(layer * 32 + s) * 128) * 128 + kvh * 64; cV = A.in[3] + ((size_t)(layer * 32 + s) * 128) * 128 + kvh * 64;
                kind = 0; qcol = PC_BQ + h * 64; qpos = i; nct = 4; cstride = 128; npt = 1; prow0 = NPROMPT + s * 32; kcol = PC_BK + kvh * 64; vcol = PC_BV + kvh * 64; kpos0 = -128; has_sink = true; zcol = PC_BZ + h * 64; ycol = YC_B + h * 64; }
            if (has_sink) sink = A.in[13][layer * 8 + h];
            attn_simple(F, A, scr, (const LAS float*)(F.lds + NW * 16384), (const LAS float*)(F.lds + NW * 16384 + 1024), lane, kind, qrow, qcol, h, qpos, writer, nct, cK, cV, cstride, npt, prow0, kcol, vcol, kpos0, sink, has_sink, zcol, ycol);
        } else {
            u -= U_ATT;
            int T, row0, g; float* avs = nullptr;
            if (u < U_AP) { g = u & 3; const int n = (u >> 2) & 15, b = u >> 6; T = 128; row0 = b * SEQ + n * 128; }
            else { u -= U_AP; g = u & 3; const int s = u >> 2; T = 32; row0 = NPROMPT + s * 32; avs = F.out + O_AVS + ((size_t)layer * NSAMP + s * 32) * 256; }
            mixa_simple(F, A, scr, lane, layer, T, row0, g, avs);
        }
    }
}


namespace mx {
typedef float f32x16 __attribute__((ext_vector_type(16)));
typedef float f32x2 __attribute__((ext_vector_type(2)));
typedef short s16x4 __attribute__((ext_vector_type(4)));
typedef unsigned u32x2 __attribute__((ext_vector_type(2)));
typedef __bf16 bf16x2_t __attribute__((ext_vector_type(2)));
constexpr float LOG2E = 1.4426950408889634f;
constexpr int TABW = 264;
__device__ __forceinline__ int crow(int r, int hi) { return (r & 3) + 8 * (r >> 2) + 4 * hi; }
__device__ __forceinline__ unsigned cvtpk(float lo, float hi) { f32x2 v = {lo, hi}; bf16x2_t b = __builtin_convertvector(v, bf16x2_t); return __builtin_bit_cast(unsigned, b); }
__device__ __forceinline__ s16x4 vtr(const LAS unsigned char* p) { typedef short v4i16_t __attribute__((ext_vector_type(4))); return __builtin_bit_cast(s16x4, __builtin_amdgcn_ds_read_tr16_b64_v4i16((LAS v4i16_t*)p)); }
__device__ __forceinline__ float silu(float z) { return z * __builtin_amdgcn_rcpf(1.f + __builtin_amdgcn_exp2f(-z * LOG2E)); }
__device__ __forceinline__ float u2f(unsigned u) { return __builtin_bit_cast(float, u); }
__device__ __forceinline__ float bfl(unsigned w) { return __builtin_bit_cast(float, w << 16); }
__device__ __forceinline__ float bfh(unsigned w) { return __builtin_bit_cast(float, w & 0xffff0000u); }

__device__ __forceinline__ void pv_tile(f32x16 (&o)[2], const LAS unsigned char* vb, const v4u (&pw)[4]) {
#pragma unroll
    for (int d0 = 0; d0 < 2; ++d0)
#pragma unroll
        for (int ks = 0; ks < 4; ++ks) {
            const s16x4 lo = vtr(vb + d0 * 4096 + ks * 1024), hi = vtr(vb + d0 * 4096 + ks * 1024 + 512);
            const bf16x8 vf = (bf16x8){lo[0], lo[1], lo[2], lo[3], hi[0], hi[1], hi[2], hi[3]};
            o[d0] = __builtin_amdgcn_mfma_f32_32x32x16_bf16(__builtin_bit_cast(bf16x8, pw[ks]), vf, o[d0], 0, 0, 0);
        }
}

__device__ __forceinline__ void attn_tile(f32x16 (&o)[2], float& m, float& l, const bf16x8 (&qr)[4], f32x16 p0, f32x16 p1,
                                          const LAS unsigned char* Kimg, const LAS unsigned char* Vimg, LAS float* wsf, int r32, int hi) {
    const LAS unsigned char* kb = Kimg + hi * 1024 + r32 * 16;
#pragma unroll
    for (int d0 = 0; d0 < 4; ++d0) {
        const bf16x8 k0 = *(const LAS bf16x8*)(kb + d0 * 2048), k1 = *(const LAS bf16x8*)(kb + d0 * 2048 + 512);
        p0 = __builtin_amdgcn_mfma_f32_32x32x16_bf16(k0, qr[d0], p0, 0, 0, 0);
        p1 = __builtin_amdgcn_mfma_f32_32x32x16_bf16(k1, qr[d0], p1, 0, 0, 0);
    }
    float mt = fmaxf(p0[0], p1[0]);
#pragma unroll
    for (int r = 1; r < 16; ++r) mt = fmaxf(mt, fmaxf(p0[r], p1[r]));
    mt = fmaxf(mt, __shfl_xor(mt, 32));
    if (__any(mt > m)) {
        const float mn = fmaxf(m, mt);
        const float f = __builtin_amdgcn_exp2f((m - mn) * LOG2E);
        m = mn; l *= f;
        if (hi == 0) wsf[r32] = f;
        asm volatile("s_waitcnt lgkmcnt(0)" ::: "memory");
#pragma unroll
        for (int rg = 0; rg < 4; ++rg) { const f32x4 fv = *(const LAS f32x4*)(wsf + 8 * rg + 4 * hi);
#pragma unroll
            for (int e = 0; e < 4; ++e) { o[0][4 * rg + e] *= fv[e]; o[1][4 * rg + e] *= fv[e]; } }
        asm volatile("s_waitcnt lgkmcnt(0)" ::: "memory");
    }
    const float nm = -m * LOG2E;
    float rs = 0.f;
#pragma unroll
    for (int r = 0; r < 16; ++r) { p0[r] = __builtin_amdgcn_exp2f(fmaf(p0[r], LOG2E, nm)); p1[r] = __builtin_amdgcn_exp2f(fmaf(p1[r], LOG2E, nm)); rs += p0[r] + p1[r]; }
    l += rs;
    v4u pw[4];
    pw[0] = (v4u){cvtpk(p0[0], p0[1]), cvtpk(p0[2], p0[3]), cvtpk(p0[4], p0[5]), cvtpk(p0[6], p0[7])};
    pw[1] = (v4u){cvtpk(p0[8], p0[9]), cvtpk(p0[10], p0[11]), cvtpk(p0[12], p0[13]), cvtpk(p0[14], p0[15])};
    pw[2] = (v4u){cvtpk(p1[0], p1[1]), cvtpk(p1[2], p1[3]), cvtpk(p1[4], p1[5]), cvtpk(p1[6], p1[7])};
    pw[3] = (v4u){cvtpk(p1[8], p1[9]), cvtpk(p1[10], p1[11]), cvtpk(p1[12], p1[13]), cvtpk(p1[14], p1[15])};
    const LAS unsigned char* vb = Vimg + ((r32 >> 4) & 1) * 32 + (r32 & 3) * 8 + (4 * hi + ((r32 & 15) >> 2)) * 64;
    pv_tile(o, vb, pw);
}

__device__ __forceinline__ void wave_epilogue(const f32x16 (&o)[2], bool use_scale, float scale_q, LAS float* wsf, const bf16* P, bf16* Y, int row0, int ucol, int zcol, int ycol, int r32, int hi) {
    f32x4 sc[4];
    if (use_scale) {
        if (hi == 0) wsf[r32] = scale_q;
        asm volatile("s_waitcnt lgkmcnt(0)" ::: "memory");
#pragma unroll
        for (int rg = 0; rg < 4; ++rg) sc[rg] = *(const LAS f32x4*)(wsf + 8 * rg + 4 * hi);
        asm volatile("s_waitcnt lgkmcnt(0)" ::: "memory");
    } else {
#pragma unroll
        for (int rg = 0; rg < 4; ++rg) sc[rg] = (f32x4){1.f, 1.f, 1.f, 1.f};
    }
#pragma unroll
    for (int r = 0; r < 16; ++r) {
        const size_t row = (size_t)(row0 + crow(r, hi));
        const bf16* pr = P + row * NIN + r32; bf16* yr = Y + row * D + ycol + r32;
#pragma unroll
        for (int d0 = 0; d0 < 2; ++d0) {
            float v = o[d0][r] * sc[r >> 2][r & 3] * silu(bf2f(pr[zcol + 32 * d0]));
            if (ucol >= 0) v *= bf2f(pr[ucol + 32 * d0]);
            yr[32 * d0] = (bf16)f2bf(v);
        }
    }
}

struct AttnUnit {
    int kind;
    int np;
    int T;
    int nct;
    const float* cK; const float* cV; int cpitch;
    int prow0;
    int kcol, vcol;
    int last_valid;
    int dc0;
    bool active; int plane, qrow0, qcol, h, qi0, zcol, ycol; float sink;
};

#define MX_PREFETCH(t_) do { const int t__ = (t_); const int nvalid__ = (t__ == U.T - 1) ? U.last_valid : 64; \
    if (t__ < U.nct) { const float* kp__ = U.cK + (size_t)(t__ * 64 + kkey) * U.cpitch + kd; const float* vp__ = U.cV + (size_t)(t__ * 64 + vkey) * U.cpitch + vd; \
        _Pragma("unroll") for (int p = 0; p < 2; ++p) if (p < U.np) { \
            pre[2 * p][0] = *(const GAS v4u*)(kp__ + 64 * p); pre[2 * p + 1][0] = *(const GAS v4u*)(kp__ + 64 * p + 4); \
            pre[2 * p][1] = *(const GAS v4u*)(vp__ + 64 * p); pre[2 * p + 1][1] = *(const GAS v4u*)(vp__ + 64 * p + 4); } \
    } else { const int pr__ = U.prow0 + (t__ - U.nct) * 64; \
        const bf16* kp__ = F.P() + (size_t)(pr__ + kkey) * NIN + U.kcol + kd; const bf16* vp__ = F.P() + (size_t)(pr__ + vkey) * NIN + U.vcol + vd; \
        _Pragma("unroll") for (int p = 0; p < 4; ++p) if (p < U.np) { \
            pre[p][0] = (kkey < nvalid__) ? *(const GAS v4u*)(kp__ + 64 * p) : (v4u){0u, 0u, 0u, 0u}; \
            pre[p][1] = (vkey < nvalid__) ? *(const GAS v4u*)(vp__ + 64 * p) : (v4u){0u, 0u, 0u, 0u}; } } } while (0)
#define MX_STAGE(t_) do { const int t__ = (t_); LAS unsigned char* dst__ = kv + w * 1024 + lane * 16; \
    if (t__ < U.nct) { \
        _Pragma("unroll") for (int p = 0; p < 2; ++p) if (p < U.np) { \
            _Pragma("unroll") for (int x = 0; x < 2; ++x) { const v4u a = pre[2 * p][x], b = pre[2 * p + 1][x]; v4u o_; \
                o_.x = cvtpk(u2f(a.x), u2f(a.y)); o_.y = cvtpk(u2f(a.z), u2f(a.w)); \
                o_.z = cvtpk(u2f(b.x), u2f(b.y)); o_.w = cvtpk(u2f(b.z), u2f(b.w)); \
                *(LAS v4u*)(dst__ + p * 16384 + x * 8192) = o_; } } \
    } else { \
        _Pragma("unroll") for (int p = 0; p < 4; ++p) if (p < U.np) { *(LAS v4u*)(dst__ + p * 16384) = pre[p][0]; *(LAS v4u*)(dst__ + p * 16384 + 8192) = pre[p][1]; } } } while (0)

__device__ __forceinline__ void attn_unit(Frame& F, const AttnUnit& U, LAS unsigned char* kv, const LAS float* tabB, const LAS float* tabC, float cconst  ) {
    const int lane = F.lane, w = F.wave, r32 = lane & 31, hi = lane >> 5;
    LAS float* wsf = (LAS float*)(F.lds + WSF_OFF) + w * 64;
    v4u pre[4][2];
    const int kkey = lane, vkey = 16 * (w & 3) + (lane >> 2);
    const int kd = 8 * w, vd = (w >> 2) * 32 + (lane & 3) * 8;
    bf16x8 qr[4]; f32x16 o[2]; float m, l;
    o[0] = (f32x16){}; o[1] = (f32x16){};
    const int qi = U.qi0 + r32;
    if (U.active) {
        const bf16* qp = F.P() + (size_t)(U.qrow0 + r32) * NIN + U.qcol + 8 * hi;
#pragma unroll
        for (int d0 = 0; d0 < 4; ++d0) { const v4u x = *(const GAS v4u*)(qp + 16 * d0);
            v4u y; y.x = cvtpk(bfl(x.x) * 0.125f, bfh(x.x) * 0.125f); y.y = cvtpk(bfl(x.y) * 0.125f, bfh(x.y) * 0.125f); y.z = cvtpk(bfl(x.z) * 0.125f, bfh(x.z) * 0.125f); y.w = cvtpk(bfl(x.w) * 0.125f, bfh(x.w) * 0.125f);
            qr[d0] = __builtin_bit_cast(bf16x8, y); }
    } else {
#pragma unroll
        for (int d0 = 0; d0 < 4; ++d0) qr[d0] = (bf16x8){};
    }
    if (U.kind == 0) { m = U.sink; l = (hi == 0) ? 1.f : 0.f; } else { m = -1e30f; l = 0.f; }
    const int cp = (qi + 1) & 1;
    const LAS float* ltab = (U.kind == 0 ? tabB : tabC) + (U.h * 2 + cp) * TABW + (191 - qi + 4 * hi + cp);
    MX_PREFETCH(0);
    for (int t = 0; t < U.T; ++t) {
        __syncthreads();
        MX_STAGE(t);
        __syncthreads();
        if (t + 1 < U.T) MX_PREFETCH(t + 1);
        if (U.active) {
            const int dc = U.dc0 + t;
            f32x16 p0, p1;
            if (dc >= -2) {
                const LAS float* tp = ltab + dc * 64;
#pragma unroll
                for (int rg = 0; rg < 4; ++rg)
#pragma unroll
                    for (int pp = 0; pp < 2; ++pp) { const f32x2 a = *(const LAS f32x2*)(tp + 8 * rg + 2 * pp), b = *(const LAS f32x2*)(tp + 32 + 8 * rg + 2 * pp);
                        p0[4 * rg + 2 * pp] = a.x; p0[4 * rg + 2 * pp + 1] = a.y; p1[4 * rg + 2 * pp] = b.x; p1[4 * rg + 2 * pp + 1] = b.y; }
            } else {
#pragma unroll
                for (int r = 0; r < 16; ++r) { p0[r] = cconst; p1[r] = cconst; }
            }
            if (t == U.T - 1 && U.last_valid == 32) {
#pragma unroll
                for (int r = 0; r < 16; ++r) p1[r] = -1e30f;
            }
            attn_tile(o, m, l, qr, p0, p1, kv + U.plane * 16384, kv + U.plane * 16384 + 8192, wsf, r32, hi);
        }
    }
    if (U.active) {
        l += __shfl_xor(l, 32);
        wave_epilogue(o, true, 1.f / l, wsf, F.P(), F.Y(), U.qrow0, -1, U.zcol, U.ycol, r32, hi);
    }
}

__device__ __forceinline__ void mixa_unit(Frame& F, const Args& A, int layer, int row0, int T, float* avs  , LAS unsigned char* kv) {
    const int lane = F.lane, w = F.wave, r32 = lane & 31, hi = lane >> 5;
    __syncthreads();
    {
        const f32x4 ga = *(const GAS f32x4*)(A.in[10] + (size_t)layer * 256 + 4 * lane);
        const int g = lane >> 4, cg = 4 * (lane & 15);
        const int TS = T < 64 ? 64 : T;
        for (int s = w; s < TS; s += 8) {
            LAS u32x2* dst = (LAS u32x2*)(kv + g * 16384 + (s >> 6) * 8192 + (cg >> 5) * 4096 + (s & 63) * 64 + (cg & 31) * 2);
            if (s < T) {
                const u32x2 x = *(const GAS u32x2*)(F.P() + (size_t)(row0 + s) * NIN + PC_AV + 4 * lane);
                float a = bfl(x.x), b = bfh(x.x), c = bfl(x.y), d = bfh(x.y);
                const float rstd = 1.f / sqrtf(wave_sum((a * a + b * b) + (c * c + d * d)) * (1.f / 256.f) + RMS_EPS);
                a *= rstd * ga.x; b *= rstd * ga.y; c *= rstd * ga.z; d *= rstd * ga.w;
                if (avs) *(GAS f32x4*)(avs + (size_t)s * 256 + 4 * lane) = (f32x4){a, b, c, d};
                *dst = (u32x2){cvtpk(a, b), cvtpk(c, d)};
            } else *dst = (u32x2){0u, 0u};
        }
    }
    __syncthreads();
    const int g = w >> 1;
    const bf16* Wg = F.Wtril() + (size_t)(layer * 4 + g) * 128 * 128;
    const float* bsg = A.in[12] + (size_t)(layer * 4 + g) * 128;
    for (int i = 0; i < 2; ++i) {
        const int tb = 2 * (w & 1) + i;
        if (tb * 32 >= T) break;
        f32x16 o[2];
#pragma unroll
        for (int rg = 0; rg < 4; ++rg) { const f32x4 bv = *(const GAS f32x4*)(bsg + tb * 32 + 8 * rg + 4 * hi);
#pragma unroll
            for (int e = 0; e < 4; ++e) { o[0][4 * rg + e] = bv[e]; o[1][4 * rg + e] = bv[e]; } }
        const int nst = (tb >= 2) ? 2 : 1;
        for (int st = 0; st < nst; ++st) {
            v4u pw[4];
            const bf16* wp = Wg + (size_t)(tb * 32 + r32) * 128 + st * 64 + 4 * hi;
#pragma unroll
            for (int ks = 0; ks < 4; ++ks) { const u32x2 a = *(const GAS u32x2*)(wp + 16 * ks), b = *(const GAS u32x2*)(wp + 16 * ks + 8); pw[ks] = (v4u){a.x, a.y, b.x, b.y}; }
            const LAS unsigned char* vb = kv + g * 16384 + st * 8192 + ((r32 >> 4) & 1) * 32 + (r32 & 3) * 8 + (4 * hi + ((r32 & 15) >> 2)) * 64;
            pv_tile(o, vb, pw);
        }
        wave_epilogue(o, false, 1.f, nullptr, F.P(), F.Y(), row0 + tb * 32, PC_AU + g * 64, PC_AZ + g * 64, YC_A + g * 64, r32, hi);
    }
}
}

#ifndef MIX_MASK
#define MIX_MASK 63
#endif
constexpr int MU_CP = 256, MU_CS = 128, MU_BS = 32, MU_BP = 512, MU_AP = 128, MU_AS = 32;
constexpr int MU_TOTAL = MU_CP + MU_CS + MU_BS + MU_BP + MU_AP + MU_AS;
__device__ __forceinline__ void mix_phase(Frame& F0, const Args& A, int layer) {
    Frame F = F0;
    { int tid = threadIdx.x; asm volatile("" : "+v"(tid)); F.tid = tid; F.lane = tid & 63; F.wave = __builtin_amdgcn_readfirstlane(tid >> 6); }
    LAS unsigned char* kv = F.lds + KV_OFF;
    LAS float* tabB = (LAS float*)(F.lds + TABB_OFF); LAS float* tabC = (LAS float*)(F.lds + TABC_OFF);
    __syncthreads();
    for (int i = F.tid; i < 8 * 2 * mx::TABW; i += NWAVES * 64) { const int h = i / (2 * mx::TABW), cp = (i / mx::TABW) & 1, rel = (i % mx::TABW) - cp - 191;
        tabB[i] = (rel >= -191 && rel <= 63) ? A.in[15][t5_bucket(rel) * 8 + h] : 0.f; }
    for (int i = F.tid; i < 4 * 2 * mx::TABW; i += NWAVES * 64) { const int h = i / (2 * mx::TABW), cp = (i / mx::TABW) & 1, rel = (i % mx::TABW) - cp - 191;
        const int ci = (rel < -128 ? -128 : (rel > 128 ? 128 : rel)) + 128; tabC[i] = A.in[14][((size_t)layer * 257 + ci) * 4 + h]; }
    __syncthreads();
    const int w = F.wave;
    for (int u0 = F.vcu; u0 < MU_TOTAL; u0 += F.G) {
        int u = u0;
        if (u < MU_CP + MU_CS + MU_BS + MU_BP) {
            mx::AttnUnit U; U.cK = nullptr; U.cV = nullptr; U.cpitch = 0; U.nct = 0; U.last_valid = 64; U.sink = 0.f; float cconst = 0.f;
            int ty;
            if (u < MU_CP) { ty = 0; const int n = 31 - (u >> 3), b = u & 7; const int c0 = n >= 8 ? n - 8 : 0; const int h = w >> 1;
                U.kind = 1; U.np = 4; U.T = n - c0 + 1; U.prow0 = b * SEQ + c0 * 64; U.kcol = PC_CK; U.vcol = PC_CV; U.dc0 = c0 - n;
                U.active = true; U.plane = h; U.qrow0 = b * SEQ + n * 64 + (w & 1) * 32; U.qcol = PC_CQ + h * 64; U.h = h; U.qi0 = (w & 1) * 32; U.zcol = PC_CZ + h * 64; U.ycol = YC_C + h * 64;
                cconst = A.in[14][((size_t)layer * 257) * 4 + h]; }
            else if (u < MU_CP + MU_CS) { ty = 1; u -= MU_CP; const int h = u & 3, s = u >> 2;
                U.kind = 1; U.np = 1; U.T = 9; U.nct = 8; U.cK = A.in[4] + ((size_t)(layer * 32 + s) * 512) * 256 + h * 64; U.cV = A.in[5] + ((size_t)(layer * 32 + s) * 512) * 256 + h * 64; U.cpitch = 256;
                U.prow0 = NPROMPT + s * 32; U.kcol = PC_CK + h * 64; U.vcol = PC_CV + h * 64; U.last_valid = 32; U.dc0 = -8;
                U.active = (w == 0); U.plane = 0; U.qrow0 = NPROMPT + s * 32; U.qcol = PC_CQ + h * 64; U.h = h; U.qi0 = 0; U.zcol = PC_CZ + h * 64; U.ycol = YC_C + h * 64;
                cconst = A.in[14][((size_t)layer * 257) * 4 + h]; }
            else if (u < MU_CP + MU_CS + MU_BS) { ty = 2; u -= MU_CP + MU_CS; const int s = u; const int h = w;
                U.kind = 0; U.np = 2; U.T = 3; U.nct = 2; U.cK = A.in[2] + ((size_t)(layer * 32 + s) * 128) * 128; U.cV = A.in[3] + ((size_t)(layer * 32 + s) * 128) * 128; U.cpitch = 128;
                U.prow0 = NPROMPT + s * 32; U.kcol = PC_BK; U.vcol = PC_BV; U.last_valid = 32; U.dc0 = -2;
                U.active = true; U.plane = h >> 2; U.qrow0 = NPROMPT + s * 32; U.qcol = PC_BQ + h * 64; U.h = h; U.qi0 = 0; U.zcol = PC_BZ + h * 64; U.ycol = YC_B + h * 64; U.sink = A.in[13][layer * 8 + h]; }
            else { ty = 3; u -= MU_CP + MU_CS + MU_BS; const int kvh = u & 1, n = 31 - ((u >> 1) & 31), b = u >> 6; const int c0 = n >= 2 ? n - 2 : 0; const int h = kvh * 4 + (w >> 1);
                U.kind = 0; U.np = 1; U.T = n - c0 + 1; U.prow0 = b * SEQ + c0 * 64; U.kcol = PC_BK + kvh * 64; U.vcol = PC_BV + kvh * 64; U.dc0 = c0 - n;
                U.active = true; U.plane = 0; U.qrow0 = b * SEQ + n * 64 + (w & 1) * 32; U.qcol = PC_BQ + h * 64; U.h = h; U.qi0 = (w & 1) * 32; U.zcol = PC_BZ + h * 64; U.ycol = YC_B + h * 64; U.sink = A.in[13][layer * 8 + h]; }
            if (!((MIX_MASK >> ty) & 1)) continue;
            mx::attn_unit(F, U, kv, tabB, tabC, cconst);
        } else {
            u -= MU_CP + MU_CS + MU_BS + MU_BP;
            if (u < MU_AP) { if (!((MIX_MASK >> 4) & 1)) continue; const int n = u & 15, b = u >> 4; mx::mixa_unit(F, A, layer, b * SEQ + n * 128, 128, nullptr, kv); }
            else { if (!((MIX_MASK >> 5) & 1)) continue; u -= MU_AP; const int s = u; mx::mixa_unit(F, A, layer, NPROMPT + s * 32, 32, F.out + O_AVS + ((size_t)layer * NSAMP + s * 32) * 256, kv); }
        }
    }
    __syncthreads();
}
constexpr int N_PHASES = 1 + 4 * DEPTH;
__global__ void __launch_bounds__(NWAVES * 64, 2) mk_fwd(Args args) {
    extern __shared__ __attribute__((aligned(16))) unsigned char lds[];
    Frame F;
    F.lds = (LAS unsigned char*)lds;
    F.tid = 0; F.lane = 0; F.wave = 0;
    F.G = gridDim.x; { const int bx = blockIdx.x; F.vcu = (F.G % 8 == 0) ? (bx % 8) * (F.G / 8) + bx / 8 : bx; }
    F.ws = args.ws; F.out = args.out;
    for (int u = threadIdx.x; u < (LDS_BYTES - LDSCTL_OFF) / 4; u += NWAVES * 64) ((LAS unsigned*)(F.lds + LDSCTL_OFF))[u] = 0u;
    __syncthreads();
    const int lo = args.ph_lo, hi = args.ph_hi;
    const bool multi = (hi - lo) > 1;
    XcdBarrier bar; bar.bar = (unsigned*)(F.ws + WS_CTL) + CW_BAR; bar.x = 0; bar.st = nullptr;
    if (multi) bar = xcd_barrier_post((unsigned*)(F.ws + WS_CTL) + CW_BAR, (volatile LAS unsigned*)(F.lds + MISC_OFF) + 8);
#define IN(k) (lo <= (k) && (k) < hi)
#define SEAM(k) do { if (IN(k) && IN((k) + 1)) xcd_barrier(bar); } while (0)
    if (IN(0)) { p0_prologue(F, args); SEAM(0); }
    for (int layer = 0; layer < DEPTH; ++layer) {
        const int p0 = 1 + 4 * layer;
        if (IN(p0)) {
            pg8::Gemm g{F.XN(), F.Win_t() + (size_t)layer * NIN * D, M, NIN, D}; pg8::StaticOrder S; S.init(M, NIN, F.G, (int)blockIdx.x);
            pg8::EpiP E{F.P(), F.out, layer};
            pg8::gemm_phase<pg8::EpiP, pg8::StaticOrder, true, true>(F.lds + RING_OFF, g, S, E);
            SEAM(p0);
        }
        if (IN(p0 + 1)) { mix_phase(F, args, layer); SEAM(p0 + 1); }
        if (IN(p0 + 2)) {
            pg8::Gemm g{F.Y(), F.Wout_t() + (size_t)layer * D * D, M, D, D}; pg8::StaticOrder S; S.init(M, D, F.G, (int)blockIdx.x);
            pg8::EpiF32 E{F.YF(), D};
            pg8::gemm_phase<pg8::EpiF32, pg8::StaticOrder, true, true>(F.lds + RING_OFF, g, S, E);
            SEAM(p0 + 2);
        }
        if (IN(p0 + 3)) { post_phase(F, args, layer); SEAM(p0 + 3); }
    }
#undef IN
#undef SEAM
}

constexpr int MIXK_LDS = 4 * 16384 + 1024 + 4352;
__global__ void __launch_bounds__(256) mix_simple_kernel(Args args, int layer) {
    __shared__ __attribute__((aligned(16))) unsigned char lds_m[MIXK_LDS];
    Frame F;
    F.lds = (LAS unsigned char*)lds_m;
    F.tid = threadIdx.x; F.lane = F.tid & 63; F.wave = __builtin_amdgcn_readfirstlane(F.tid >> 6);
    F.G = gridDim.x; F.vcu = blockIdx.x;
    F.ws = args.ws; F.out = args.out;
    mix_phase_simple<4>(F, args, layer);
}

#ifndef MK_SINGLE
#define MK_SINGLE 1
#endif
extern "C" void kernel_launch(void* const* d_in, const int* in_sizes, int n_in, void* d_out, int out_size, void* d_ws, size_t ws_size, hipStream_t stream) {
    static int grid = 0;
    if (grid == 0) {
        if (n_in != 16 || out_size != (int)O_END || ws_size < WS_END) { fprintf(stderr, "kernel_launch: unexpected shapes: n_in %d out %d ws %zu\n", n_in, out_size, ws_size); grid = -1; return; }
        int dev = 0, cus = 0;
        if (hipGetDevice(&dev) != hipSuccess || hipDeviceGetAttribute(&cus, hipDeviceAttributeMultiprocessorCount, dev) != hipSuccess) { grid = -1; return; }
        if (hipFuncSetAttribute((const void*)mk_fwd, hipFuncAttributeMaxDynamicSharedMemorySize, LDS_BYTES) != hipSuccess) { fprintf(stderr, "kernel_launch: hipFuncSetAttribute failed\n"); grid = -1; return; }
        (void)hipGetLastError();
        grid = cus;
    }
    if (grid < 0) return;
    (void)hipMemsetAsync((char*)d_ws + WS_CTL, 0, CTL_ZERO_BYTES, stream);
    Args a{};
    for (int i = 0; i < 16; ++i) a.in[i] = (const float*)d_in[i];
    a.out = (float*)d_out; a.ws = (unsigned char*)d_ws;
#if MK_SINGLE
    a.ph_lo = 0; a.ph_hi = N_PHASES;
    hipLaunchKernelGGL(mk_fwd, dim3(grid), dim3(NWAVES * 64), LDS_BYTES, stream, a);
#else
    for (int ph = 0; ph < N_PHASES; ++ph) {
#if MIX_MASK != 63
        if (ph >= 1 && ((ph - 1) & 3) == 1) hipLaunchKernelGGL(mix_simple_kernel, dim3(1024), dim3(256), 0, stream, a, (ph - 1) >> 2);
#endif
        a.ph_lo = ph; a.ph_hi = ph + 1; hipLaunchKernelGGL(mk_fwd, dim3(grid), dim3(NWAVES * 64), LDS_BYTES, stream, a); }
#endif
}
```

```cpp
#include <hip/hip_runtime.h>
#include <cstdio>
#include <cstdint>

constexpr int D = 1024, NPROMPT = 8 * 2048, NSAMP = 32 * 32, M = NPROMPT + NSAMP  , NIN = 3072, DEPTH = 4, SEQ = 2048;
constexpr float RMS_EPS = 1e-6f;
constexpr int PC_AU = 0, PC_AV = 256, PC_AZ = 512, PC_BQ = 768, PC_BK = 1280, PC_BV = 1408, PC_BZ = 1536, PC_CQ = 2048, PC_CK = 2304, PC_CV = 2560, PC_CZ = 2816;
constexpr int YC_A = 0, YC_B = 256, YC_C = 768;
constexpr size_t O_YP = 0, O_YS = 16777216, O_BKP = 17825792, O_BVP = 18350080, O_CKP = 18874368, O_CVP = 23068672, O_BKS = 27262976, O_BVS = 27787264, O_CKS = 28311552, O_CVS = 29360128, O_AVS = 30408704, O_END = 31457280;

namespace pg8 {
#define PG8_LAS __attribute__((address_space(3)))
typedef unsigned short bf16_t;
typedef short bf16x8 __attribute__((ext_vector_type(8)));
typedef float f32x4 __attribute__((ext_vector_type(4)));
typedef unsigned u32x4 __attribute__((ext_vector_type(4)));
constexpr int BM = 256, BK = 64, HALF = 128, HTB = HALF * BK * 2  , STAGE_BYTES = 8 * HTB, NXCD = 8, WGM = 8;

__host__ __device__ __forceinline__ int lds_byte(int r, int c) { const int st = (r >> 4) * 2 + (c >> 5), rr = r & 15, cc = c & 31, ob = rr * 64 + cc * 2; return st * 1024 + (ob ^ (((ob >> 9) & 1) << 5)); }
__host__ __device__ __forceinline__ void stage_rc(int b, int& R, int& C) { const int st = b / 1024, sb = b % 1024, swz = sb ^ (((sb >> 9) & 1) << 5); R = (st >> 1) * 16 + swz / 64; C = (st & 1) * 32 + (swz % 64) / 2; }
__host__ __device__ __forceinline__ int perm32(int rho) { const int n = rho >> 4, i = rho & 15; return 8 * (i >> 2) + 4 * n + (i & 3); }

struct Unit { int pm, pn; };
struct Gemm { const bf16_t* A; const bf16_t* Bt; int M, N, K; };

struct StaticOrder {
    int nM, nN, nwg, G, c;
    __host__ __device__ void init(int M, int N, int G_, int c_) { nM = M / BM; nN = N / BM; nwg = nM * nN; G = G_; c = c_; }
    __host__ __device__ bool next(int i, Unit& u) const {
        const long L = (long)i * G + c; if (L >= nwg) return false;
        int wgid = (int)L; { const int q = nwg / NXCD, r = nwg % NXCD, xcd = wgid % NXCD, off = wgid / NXCD; wgid = (xcd < r ? xcd * (q + 1) : r * (q + 1) + (xcd - r) * q) + off; }
        const int nig = WGM * nN, gid = wgid / nig, fm = gid * WGM, gsz = (nM - fm) < WGM ? (nM - fm) : WGM;
        u.pm = fm + ((wgid % nig) % gsz); u.pn = (wgid % nig) / gsz; return true;
    }
    __device__ __forceinline__ void a_ready(const Unit&) const {}
    __device__ __forceinline__ void done(const Unit&) const {}
};


__device__ __forceinline__ unsigned cvt_pk_bf16(float lo, float hi) { unsigned r; asm volatile("v_cvt_pk_bf16_f32 %0, %1, %2" : "=v"(r) : "v"(lo), "v"(hi)); return r; }

struct EpiP {
    static constexpr bool PERM = true, AFTER_DRAIN = false;
    bf16_t* O; float* out; int layer;
    __device__ __forceinline__ void operator()(const f32x4 (&acc)[2][2][4][2], const Unit& u, int wr, int wc, int fr, int fq) const {
        const int row0 = u.pm * BM + wr * 64 + fr; const int col0 = u.pn * BM + wc * 32 + 8 * fq;
#pragma unroll
        for (int ai = 0; ai < 2; ++ai)
#pragma unroll
            for (int m = 0; m < 4; ++m) { bf16_t* rowp = O + (size_t)(row0 + ai * HALF + m * 16) * NIN + col0;
#pragma unroll
                for (int bj = 0; bj < 2; ++bj) { const f32x4 v0 = acc[ai][bj][m][0], v1 = acc[ai][bj][m][1];
                    u32x4 w; w.x = cvt_pk_bf16(v0[0], v0[1]); w.y = cvt_pk_bf16(v0[2], v0[3]); w.z = cvt_pk_bf16(v1[0], v1[1]); w.w = cvt_pk_bf16(v1[2], v1[3]);
                    *(u32x4*)(rowp + bj * HALF) = w; } }
        if (u.pn == 5 || u.pn == 9 || u.pn == 10) {
            const int cc = wc * 32 + 8 * fq;
#pragma unroll
            for (int ai = 0; ai < 2; ++ai)
#pragma unroll
                for (int m = 0; m < 4; ++m) {
                    const int r = row0 + ai * HALF + m * 16;
                    float* d0 = nullptr; float* d1 = nullptr;
                    if (u.pn == 5) {
                        if (r >= NPROMPT) { const size_t o = ((size_t)layer * NSAMP + (r - NPROMPT)) * 128 + cc; d0 = out + O_BKS + o; d1 = out + O_BVS + o; }
                        else { const int t = r & (SEQ - 1), b = r >> 11; if (t >= SEQ - 128) { const size_t o = (((size_t)layer * 8 + b) * 128 + (t - (SEQ - 128))) * 128 + cc; d0 = out + O_BKP + o; d1 = out + O_BVP + o; } }
                    } else {
                        const size_t os = (u.pn == 9) ? O_CKS : O_CVS, op = (u.pn == 9) ? O_CKP : O_CVP;
                        if (r >= NPROMPT) { const size_t o = ((size_t)layer * NSAMP + (r - NPROMPT)) * 256 + cc; d0 = out + os + o; d1 = d0 + 128; }
                        else { const int t = r & (SEQ - 1), b = r >> 11; if (t >= SEQ - 512) { const size_t o = (((size_t)layer * 8 + b) * 512 + (t - (SEQ - 512))) * 256 + cc; d0 = out + op + o; d1 = d0 + 128; } }
                    }
                    if (d0) { *(f32x4*)(d0) = acc[ai][0][m][0]; *(f32x4*)(d0 + 4) = acc[ai][0][m][1]; *(f32x4*)(d1) = acc[ai][1][m][0]; *(f32x4*)(d1 + 4) = acc[ai][1][m][1]; }
                }
        }
    }
};
struct EpiF32 {
    static constexpr bool PERM = false, AFTER_DRAIN = false;
    float* C; int ldc;
    __device__ __forceinline__ void operator()(const f32x4 (&acc)[2][2][4][2], const Unit& u, int wr, int wc, int fr, int fq) const {
        const int row0 = u.pm * BM + wr * 64 + fr, col0 = u.pn * BM + wc * 32 + 4 * fq;
#pragma unroll
        for (int ai = 0; ai < 2; ++ai)
#pragma unroll
            for (int m = 0; m < 4; ++m) { float* rowp = C + (size_t)(row0 + ai * HALF + m * 16) * ldc + col0;
#pragma unroll
                for (int bj = 0; bj < 2; ++bj)
#pragma unroll
                    for (int n = 0; n < 2; ++n) *(f32x4*)(rowp + bj * HALF + n * 16) = acc[ai][bj][m][n]; }
    }
};

template <class Epi, class Sched, bool ALIGN_EPI = false, bool SP2 = false>
__device__ __forceinline__ void gemm_phase(PG8_LAS unsigned char* lds, const Gemm g, const Sched& S, const Epi& E) {
    int tid_ = threadIdx.x; asm volatile("" : "+v"(tid_));
    const int tid = tid_, wid = __builtin_amdgcn_readfirstlane(tid >> 6), lane = tid & 63, wr = wid >> 2, wc = wid & 3, fr = lane & 15, fq = lane >> 4;
    const int K = g.K, nt = K / BK;
    unsigned voffA[2], voffB[2];
#pragma unroll
    for (int i = 0; i < 2; ++i) { int R, C; stage_rc(tid * 16 + i * 8192, R, C); const int Rb = Epi::PERM ? ((R & ~31) + perm32(R & 31)) : R;
        voffA[i] = (unsigned)(R * K + C) * 2u; voffB[i] = (unsigned)(Rb * K + C) * 2u; }
    const size_t kstep = (size_t)(BK * 2);
    const size_t hstep = (size_t)HALF * K * 2;
    const size_t tstep = 2 * hstep;
    const unsigned ldsw = (unsigned)wid * 1024u;
    const int aoff = lds_byte(wr * 64 + fr, fq * 8), boff = lds_byte(wc * 32 + fr, fq * 8);
#define PG8_SA(b, h) (((b) * 2 + (h)) * HTB)
#define PG8_SB(b, h) ((4 + (b) * 2 + (h)) * HTB)
#define PG8_STAGE(bufoff, gbase, voff) do { _Pragma("unroll") for (int _i = 0; _i < 2; ++_i) \
        __builtin_amdgcn_global_load_lds((const unsigned*)((const char*)(gbase) + (voff)[_i]), (PG8_LAS unsigned*)(lds + (bufoff) + ldsw + _i * 8192), 16, 0, 0); } while (0)
#define PG8_LDA(dst, b, h) do { _Pragma("unroll") for (int m = 0; m < 4; ++m) _Pragma("unroll") for (int k = 0; k < 2; ++k) dst[m][k] = *(const PG8_LAS bf16x8*)(lds + PG8_SA(b, h) + aoff + m * 2048 + k * 1024); } while (0)
#define PG8_LDB(dst, b, h) do { _Pragma("unroll") for (int n = 0; n < 2; ++n) _Pragma("unroll") for (int k = 0; k < 2; ++k) dst[n][k] = *(const PG8_LAS bf16x8*)(lds + PG8_SB(b, h) + boff + n * 2048 + k * 1024); } while (0)
#define PG8_MMA(ai, bj, At, Bt) do { __builtin_amdgcn_s_setprio(1); _Pragma("unroll") for (int m = 0; m < 4; ++m) _Pragma("unroll") for (int n = 0; n < 2; ++n) _Pragma("unroll") for (int k = 0; k < 2; ++k) \
        acc[ai][bj][m][n] = __builtin_amdgcn_mfma_f32_16x16x32_bf16(Bt[n][k], At[m][k], acc[ai][bj][m][n], 0, 0, 0); __builtin_amdgcn_s_setprio(0); } while (0)
#define PG8_WAIT_V(n) asm volatile("s_waitcnt vmcnt(" #n ")" ::: "memory")
#define PG8_WAIT_L(n) asm volatile("s_waitcnt lgkmcnt(" #n ")" ::: "memory")
#define PG8_BAR __builtin_amdgcn_s_barrier()
#define PG8_SCHED __builtin_amdgcn_sched_barrier(0)
    Unit cur, nxt; int ui = 0;
    if (!S.next(0, cur)) return;
    f32x4 acc[2][2][4][2];
#pragma unroll
    for (int a = 0; a < 2; ++a)
#pragma unroll
        for (int b = 0; b < 2; ++b)
#pragma unroll
            for (int m = 0; m < 4; ++m)
#pragma unroll
                for (int n = 0; n < 2; ++n) acc[a][b][m][n] = (f32x4){0.f, 0.f, 0.f, 0.f};
    bf16x8 At[4][2], B0[2][2], B1[2][2];
    const char* cA = (const char*)g.A + (size_t)cur.pm * tstep; const char* cB = (const char*)g.Bt + (size_t)cur.pn * tstep;
    S.a_ready(cur);
    if constexpr (SP2) {
        PG8_STAGE(PG8_SB(0, 0), cB, voffB); PG8_STAGE(PG8_SB(0, 1), cB + hstep, voffB); PG8_STAGE(PG8_SA(0, 0), cA, voffA); PG8_STAGE(PG8_SA(0, 1), cA + hstep, voffA);
        if (wr == 1) PG8_BAR;
        PG8_WAIT_V(2); PG8_BAR;
        PG8_STAGE(PG8_SB(1, 0), cB + kstep, voffB); PG8_STAGE(PG8_SA(1, 0), cA + kstep, voffA); PG8_STAGE(PG8_SB(1, 1), cB + hstep + kstep, voffB);
        PG8_WAIT_V(6); PG8_BAR;
    } else {
        PG8_STAGE(PG8_SB(0, 0), cB, voffB); PG8_STAGE(PG8_SA(0, 0), cA, voffA); PG8_STAGE(PG8_SB(0, 1), cB + hstep, voffB); PG8_STAGE(PG8_SA(0, 1), cA + hstep, voffA);
        if (wr == 1) PG8_BAR;
        PG8_WAIT_V(4); PG8_BAR;
        PG8_STAGE(PG8_SB(1, 0), cB + kstep, voffB); PG8_STAGE(PG8_SA(1, 0), cA + kstep, voffA); PG8_STAGE(PG8_SB(1, 1), cB + hstep + kstep, voffB);
        PG8_WAIT_V(6); PG8_BAR;
    }
    for (;;) {
        const bool has_next = S.next(ui + 1, nxt);
        const char* nA = has_next ? (const char*)g.A + (size_t)nxt.pm * tstep : cA; const char* nB = has_next ? (const char*)g.Bt + (size_t)nxt.pn * tstep : cB;
        for (int t = 0; t < nt; t += 2) {
            const bool last = (t == nt - 2);
            const char* a1 = cA + (size_t)(t + 1) * kstep;
            const char* a2 = last ? nA : cA + (size_t)(t + 2) * kstep; const char* b2 = last ? nB : cB + (size_t)(t + 2) * kstep;
            const char* a3 = a2 + kstep; const char* b3 = b2 + kstep;
            if (last && has_next) S.a_ready(nxt);
            if constexpr (SP2) {
            PG8_LDB(B0, 0, 0); PG8_LDB(B1, 0, 1); PG8_SCHED; PG8_LDA(At, 0, 0); PG8_STAGE(PG8_SA(1, 1), a1 + hstep, voffA);
            PG8_WAIT_V(8); PG8_WAIT_L(0); PG8_BAR; PG8_MMA(0, 0, At, B0); PG8_MMA(0, 1, At, B1); PG8_BAR; PG8_SCHED;
            PG8_LDA(At, 0, 1); PG8_STAGE(PG8_SB(0, 0), b2, voffB); PG8_STAGE(PG8_SB(0, 1), b2 + hstep, voffB); PG8_STAGE(PG8_SA(0, 0), a2, voffA);
            PG8_WAIT_V(8); PG8_WAIT_L(0); PG8_BAR; PG8_MMA(1, 0, At, B0); PG8_MMA(1, 1, At, B1); PG8_BAR; PG8_SCHED;
            PG8_LDB(B0, 1, 0); PG8_LDB(B1, 1, 1); PG8_SCHED; PG8_LDA(At, 1, 0); PG8_STAGE(PG8_SA(0, 1), a2 + hstep, voffA);
            PG8_WAIT_V(8); PG8_WAIT_L(0); PG8_BAR; PG8_MMA(0, 0, At, B0); PG8_MMA(0, 1, At, B1); PG8_BAR; PG8_SCHED;
            PG8_LDA(At, 1, 1); PG8_STAGE(PG8_SB(1, 0), b3, voffB); PG8_STAGE(PG8_SB(1, 1), b3 + hstep, voffB); PG8_STAGE(PG8_SA(1, 0), a3, voffA);
            PG8_WAIT_V(8); PG8_WAIT_L(0); PG8_BAR; PG8_MMA(1, 0, At, B0); PG8_MMA(1, 1, At, B1); PG8_BAR; PG8_SCHED;
            } else {
            PG8_LDB(B0, 0, 0); PG8_SCHED; PG8_LDA(At, 0, 0); PG8_STAGE(PG8_SA(1, 1), a1 + hstep, voffA);
            PG8_WAIT_L(8); PG8_BAR; PG8_WAIT_L(0); PG8_MMA(0, 0, At, B0); PG8_BAR; PG8_SCHED;
            PG8_LDB(B1, 0, 1); PG8_STAGE(PG8_SB(0, 0), b2, voffB);
            PG8_BAR; PG8_WAIT_L(0); PG8_MMA(0, 1, At, B1); PG8_BAR;
            PG8_LDA(At, 0, 1); PG8_STAGE(PG8_SA(0, 0), a2, voffA);
            PG8_BAR; PG8_WAIT_L(0); PG8_MMA(1, 0, At, B0); PG8_BAR; PG8_SCHED;
            PG8_STAGE(PG8_SB(0, 1), b2 + hstep, voffB);
            PG8_WAIT_V(6); PG8_BAR; PG8_MMA(1, 1, At, B1); PG8_BAR;
            PG8_LDB(B0, 1, 0); PG8_SCHED; PG8_LDA(At, 1, 0); PG8_STAGE(PG8_SA(0, 1), a2 + hstep, voffA);
            PG8_WAIT_L(8); PG8_BAR; PG8_WAIT_L(0); PG8_MMA(0, 0, At, B0); PG8_BAR; PG8_SCHED;
            PG8_LDB(B1, 1, 1); PG8_STAGE(PG8_SB(1, 0), b3, voffB);
            PG8_BAR; PG8_WAIT_L(0); PG8_MMA(0, 1, At, B1); PG8_BAR;
            PG8_LDA(At, 1, 1); PG8_STAGE(PG8_SA(1, 0), a3, voffA);
            PG8_BAR; PG8_WAIT_L(0); PG8_MMA(1, 0, At, B0); PG8_BAR; PG8_SCHED;
            PG8_STAGE(PG8_SB(1, 1), b3 + hstep, voffB);
            PG8_WAIT_V(6); PG8_BAR; PG8_MMA(1, 1, At, B1); PG8_BAR;
            }
        }
        if constexpr (ALIGN_EPI) { if (wr == 0) PG8_BAR; }
        if constexpr (!Epi::AFTER_DRAIN) { E(acc, cur, wr, wc, fr, fq); S.done(cur); }
        if (!has_next) break;
#pragma unroll
        for (int a = 0; a < 2; ++a)
#pragma unroll
            for (int b = 0; b < 2; ++b)
#pragma unroll
                for (int m = 0; m < 4; ++m)
#pragma unroll
                    for (int n = 0; n < 2; ++n) acc[a][b][m][n] = (f32x4){0.f, 0.f, 0.f, 0.f};
        cur = nxt; cA = nA; cB = nB; ++ui;
        if constexpr (ALIGN_EPI) { if (wr == 1) PG8_BAR; }
    }
    PG8_WAIT_V(0);
    if constexpr (!ALIGN_EPI) { if (wr == 0) PG8_BAR; }
    PG8_BAR;
    if constexpr (Epi::AFTER_DRAIN) { E.fused(acc, cur, wr, wc, fr, fq, lds, wid, lane); S.done(cur); }
#undef PG8_SA
#undef PG8_SB
#undef PG8_STAGE
#undef PG8_LDA
#undef PG8_LDB
#undef PG8_MMA
#undef PG8_WAIT_V
#undef PG8_WAIT_L
#undef PG8_BAR
#undef PG8_SCHED
}
}
#define GAS __attribute__((address_space(1)))
#define LAS __attribute__((address_space(3)))
typedef unsigned short bf16;
typedef unsigned v4u __attribute__((ext_vector_type(4)));
typedef float f32x4 __attribute__((ext_vector_type(4)));
typedef short bf16x8 __attribute__((ext_vector_type(8)));
typedef GAS unsigned gu32;
typedef GAS unsigned long long gu64;
#define RLX_AGENT __ATOMIC_RELAXED, __HIP_MEMORY_SCOPE_AGENT
#define LDS_WAIT() asm volatile("s_waitcnt lgkmcnt(0)" ::: "memory")
#define VM_WAIT() asm volatile("s_waitcnt vmcnt(0)" ::: "memory")
__device__ __forceinline__ unsigned long long rt() { return __builtin_amdgcn_s_memrealtime(); }
__device__ __forceinline__ unsigned f2bf(float f) { unsigned u = __builtin_bit_cast(unsigned, f); return (u + 0x7fffu + ((u >> 16) & 1u)) >> 16; }
__device__ __forceinline__ unsigned pk2(float lo, float hi) { return f2bf(lo) | (f2bf(hi) << 16); }

#define XB_TMO      128
#define XB_XCNT(j)  (256  + 64 * (j))
#define XB_XSUB(j)  (1280 + 64 * (j))
#define XB_XGEN(j)  (2304 + 64 * (j))
#define XB_TOP      3328
#define XB_TOPGEN   3392
#define XCD_BAR_WORDS 3456
#define XB_SPIN_CAP (1u << 18)

__device__ __forceinline__ unsigned xb_ld(unsigned* p)              { return __hip_atomic_load(p, __ATOMIC_RELAXED, __HIP_MEMORY_SCOPE_AGENT); }
__device__ __forceinline__ unsigned xb_add(unsigned* p, unsigned v) { return __hip_atomic_fetch_add(p, v, __ATOMIC_RELAXED, __HIP_MEMORY_SCOPE_AGENT); }
__device__ __forceinline__ unsigned xb_xcc_id() { return (unsigned)__builtin_amdgcn_s_getreg((3 << 11) | 20) & 0xFu; }
#define XB_SPIN(cond, bar) do { unsigned _sp = 0; while (cond) { __builtin_amdgcn_s_sleep(1); \
    if ((++_sp & 255u) == 0u) { if (xb_ld(&(bar)[XB_TMO])) break; if (_sp > XB_SPIN_CAP) { atomicAdd(&(bar)[XB_TMO], 1u); break; } } } } while (0)

struct XcdBarrier {
    unsigned* bar; unsigned x;
    volatile LAS unsigned* st;
};

__device__ __forceinline__ XcdBarrier xcd_barrier_post(unsigned* bar, volatile LAS unsigned* st) {
    XcdBarrier b; b.bar = bar; b.x = xb_xcc_id(); b.st = st;
    if (threadIdx.x == 0) (void)xb_add(&bar[XB_XCNT(b.x)], 1u);
    return b;
}
__device__ __forceinline__ void xcd_barrier_complete(unsigned* bar, unsigned x, unsigned& nloc, unsigned& nx) {
    const unsigned G = gridDim.x * gridDim.y * gridDim.z;
    unsigned sum, cnt, mine, sp = 0u;
    for (;;) {
        sum = 0u; cnt = 0u; mine = 0u;
#pragma unroll
        for (unsigned j = 0; j < 16; ++j) { const unsigned c = xb_ld(&bar[XB_XCNT(j)]); sum += c; cnt += (c > 0u) ? 1u : 0u; mine = (j == x) ? c : mine; }
        if (sum == G) break;
        __builtin_amdgcn_s_sleep(1);
        if ((++sp & 255u) == 0u) { if (xb_ld(&bar[XB_TMO])) break; if (sp > XB_SPIN_CAP) { atomicAdd(&bar[XB_TMO], 1u); break; } }
    }
    nloc = mine > 0u ? mine : 1u; nx = cnt > 0u ? cnt : 1u;
}

__device__ __forceinline__ void xcd_barrier(const XcdBarrier& b) {
    asm volatile("s_waitcnt vmcnt(0)" ::: "memory");
    __syncthreads();
    if (threadIdx.x == 0) {
        unsigned* bar = b.bar;
        __builtin_amdgcn_s_waitcnt(0);
        unsigned nloc = b.st[0], nx = b.st[1];
        if (nloc == 0u) { xcd_barrier_complete(bar, b.x, nloc, nx); b.st[0] = nloc; b.st[1] = nx; }
        const unsigned old = xb_add(&bar[XB_XSUB(b.x)], 1u);
        const unsigned gen = old / nloc;
        if (old + 1u == (gen + 1u) * nloc) {
            __builtin_amdgcn_fence(__ATOMIC_RELEASE, "agent");
            asm volatile("s_waitcnt vmcnt(0)" ::: "memory");
            const unsigned og = xb_add(&bar[XB_TOP], 1u);
            const unsigned tg = og / nx;
            if (og + 1u == (tg + 1u) * nx) xb_add(&bar[XB_TOPGEN], 1u);
            else XB_SPIN(xb_ld(&bar[XB_TOPGEN]) == tg, bar);
            __builtin_amdgcn_fence(__ATOMIC_ACQUIRE, "agent");
            xb_add(&bar[XB_XGEN(b.x)], 1u);
            asm volatile("s_waitcnt vmcnt(0)" ::: "memory");
        } else {
            XB_SPIN(xb_ld(&bar[XB_XGEN(b.x)]) == gen, bar);
            __builtin_amdgcn_fence(__ATOMIC_ACQUIRE, "agent");
            asm volatile("s_waitcnt vmcnt(0)" ::: "memory");
        }
    }
    __syncthreads();
}

constexpr size_t MiB = 1u << 20;
constexpr size_t WS_CTL = 0, CTL_ZERO_BYTES = 1 * MiB;
constexpr size_t WS_WIN = 2 * MiB;
constexpr size_t WS_WOUT = 26 * MiB;
constexpr size_t WS_XN = 34 * MiB;
constexpr size_t WS_P = 68 * MiB;
constexpr size_t WS_Y = 170 * MiB;
constexpr size_t WS_YF = WS_P;
constexpr size_t WS_WTRIL = 204 * MiB;
constexpr size_t WS_END = 205 * MiB;
constexpr int CW_BAR = 4096;

constexpr int RING_OFF = 0, RING_BYTES = 131072;
constexpr int KV_OFF = 0;
constexpr int TABB_OFF = 65536, TABC_OFF = TABB_OFF + 8 * 2 * 264 * 4, WSF_OFF = TABC_OFF + 4 * 2 * 264 * 4;
constexpr int STG_OFF = 96 * 1024;
static_assert(WSF_OFF + 8 * 64 * 4 <= STG_OFF && STG_OFF + 8 * 4096 <= RING_BYTES, "MIX LDS map");
constexpr int LDSCTL_OFF = RING_BYTES, MISC_OFF = LDSCTL_OFF + 320;
constexpr int LDS_BYTES = 147456;
static_assert(MISC_OFF + 128 <= LDS_BYTES, "LDS map");
constexpr int NWAVES = 8;

struct Args { const float* in[16]; float* out; unsigned char* ws; int ph_lo, ph_hi; };
struct Frame {
    LAS unsigned char* lds;
    unsigned char* ws;
    int tid, lane, wave;
    int vcu, G;
    float* out;
    __device__ __forceinline__ bf16* Win_t() const { return (bf16*)(ws + WS_WIN); }
    __device__ __forceinline__ bf16* Wout_t() const { return (bf16*)(ws + WS_WOUT); }
    __device__ __forceinline__ bf16* XN() const { return (bf16*)(ws + WS_XN); }
    __device__ __forceinline__ bf16* P() const { return (bf16*)(ws + WS_P); }
    __device__ __forceinline__ bf16* Y() const { return (bf16*)(ws + WS_Y); }
    __device__ __forceinline__ bf16* Wtril() const { return (bf16*)(ws + WS_WTRIL); }
    __device__ __forceinline__ float* YF() const { return (float*)(ws + WS_YF); }
};

__device__ __forceinline__ float bf2f(bf16 v) { return __builtin_bit_cast(float, (unsigned)v << 16); }
__device__ __forceinline__ float wave_sum(float v) {
#pragma unroll
    for (int o = 1; o < 64; o <<= 1) v += __shfl_xor(v, o);
    return v;
}
__device__ __forceinline__ void p0_transpose_item(const float* W, int K, int N, bf16* WT, LAS float* scr, int item, int lane) {
    const int nblk = N / 32, kb = item / nblk, nb = item % nblk, k0 = 64 * kb, n0 = 32 * nb;
#pragma unroll 8
    for (int i = 0; i < 32; ++i) { const int kk = 2 * i + (lane >> 5); scr[kk * 33 + (lane & 31)] = W[(size_t)(k0 + kk) * N + n0 + (lane & 31)]; }
    LDS_WAIT(); asm volatile("" ::: "memory");
    const int c = lane & 7;
#pragma unroll
    for (int j = 0; j < 4; ++j) { const int n = (lane >> 3) + 8 * j; const LAS float* s = scr + (8 * c) * 33 + n;
        v4u o; o.x = pk2(s[0 * 33], s[1 * 33]); o.y = pk2(s[2 * 33], s[3 * 33]); o.z = pk2(s[4 * 33], s[5 * 33]); o.w = pk2(s[6 * 33], s[7 * 33]);
        *(GAS v4u*)(WT + (size_t)(n0 + n) * K + k0 + 8 * c) = o; }
    LDS_WAIT(); asm volatile("" ::: "memory");
}
__device__ __forceinline__ void rms_row_to_bf16(int lane, const float* xrow, const float* g, bf16* orow) {
    const GAS f32x4* xr = (const GAS f32x4*)xrow + lane; const GAS f32x4* gr = (const GAS f32x4*)g + lane;
    f32x4 v[4]; float s = 0.f;
#pragma unroll
    for (int j = 0; j < 4; ++j) { v[j] = xr[64 * j]; s += (v[j].x * v[j].x + v[j].y * v[j].y) + (v[j].z * v[j].z + v[j].w * v[j].w); }
    const float rstd = 1.f / sqrtf(wave_sum(s) * (1.f / D) + RMS_EPS);
    GAS unsigned long long* o8 = (GAS unsigned long long*)orow + lane;
#pragma unroll
    for (int j = 0; j < 4; ++j) { const f32x4 gg = gr[64 * j];
        o8[64 * j] = (unsigned long long)pk2(v[j].x * rstd * gg.x, v[j].y * rstd * gg.y) | ((unsigned long long)pk2(v[j].z * rstd * gg.z, v[j].w * rstd * gg.w) << 32); }
}
__device__ __forceinline__ const float* x_in_row(const Args& A, int m) { return m < NPROMPT ? A.in[0] + (size_t)m * D : A.in[1] + (size_t)(m - NPROMPT) * D; }

__device__ __forceinline__ void p0_prologue(Frame& F0, const Args& A) {
    Frame F = F0;
    { int tid = threadIdx.x; asm volatile("" : "+v"(tid)); F.tid = tid; F.lane = tid & 63; F.wave = __builtin_amdgcn_readfirstlane(tid >> 6); }
    LAS float* scr = (LAS float*)(F.lds + RING_OFF + F.wave * 16384);
    const int gw = F.vcu * NWAVES + F.wave, NGW = F.G * NWAVES;
    constexpr int I_IN = (D / 64) * (NIN / 32), I_OUT = (D / 64) * (D / 32);
    constexpr int NITEMS = DEPTH * (I_IN + I_OUT);
    for (int it = gw; it < NITEMS; it += NGW) {
        const int l = it / (I_IN + I_OUT); int r = it % (I_IN + I_OUT);
        if (r < I_IN) p0_transpose_item(A.in[8] + (size_t)l * D * NIN, D, NIN, F.Win_t() + (size_t)l * NIN * D, scr, r, F.lane);
        else p0_transpose_item(A.in[9] + (size_t)l * D * D, D, D, F.Wout_t() + (size_t)l * D * D, scr, r - I_IN, F.lane);
    }
    for (int m = gw; m < M; m += NGW) rms_row_to_bf16(F.lane, x_in_row(A, m), A.in[6], F.XN() + (size_t)m * D);
    for (int i = (F.vcu * NWAVES * 64 + F.tid) * 8; i < DEPTH * 4 * 128 * 128; i += F.G * NWAVES * 64 * 8) {
        const int s0 = i & 127, t = (i >> 7) & 127; const float* wp = A.in[11] + i;
        const f32x4 x = *(const GAS f32x4*)wp, y = *(const GAS f32x4*)(wp + 4);
        v4u o; o.x = pk2(s0 + 0 <= t ? x.x : 0.f, s0 + 1 <= t ? x.y : 0.f); o.y = pk2(s0 + 2 <= t ? x.z : 0.f, s0 + 3 <= t ? x.w : 0.f);
        o.z = pk2(s0 + 4 <= t ? y.x : 0.f, s0 + 5 <= t ? y.y : 0.f); o.w = pk2(s0 + 6 <= t ? y.z : 0.f, s0 + 7 <= t ? y.w : 0.f);
        *(GAS v4u*)(F.Wtril() + i) = o; }
}

__device__ __forceinline__ void post_phase(Frame& F0, const Args& A, int layer) {
    Frame F = F0;
    { int tid = threadIdx.x; asm volatile("" : "+v"(tid)); F.tid = tid; F.lane = tid & 63; F.wave = __builtin_amdgcn_readfirstlane(tid >> 6); }
    const int gw = F.vcu * NWAVES + F.wave, NGW = F.G * NWAVES; const int lane = F.lane;
    const GAS f32x4* gp = (const GAS f32x4*)(A.in[7] + (size_t)layer * D) + lane;
    const GAS f32x4* gn = (const GAS f32x4*)(A.in[6] + (size_t)(layer + 1 < DEPTH ? layer + 1 : 0) * D) + lane;
    for (int m = gw; m < M; m += NGW) {
        const GAS f32x4* yr = (const GAS f32x4*)(F.YF() + (size_t)m * D) + lane;
        const GAS f32x4* xr = (const GAS f32x4*)(layer == 0 ? x_in_row(A, m) : F.out + (size_t)m * D) + lane;
        GAS f32x4* xo = (GAS f32x4*)(F.out + (size_t)m * D) + lane;
        f32x4 y[4], x[4]; float s = 0.f;
#pragma unroll
        for (int j = 0; j < 4; ++j) { y[j] = yr[64 * j]; x[j] = xr[64 * j]; s += (y[j].x * y[j].x + y[j].y * y[j].y) + (y[j].z * y[j].z + y[j].w * y[j].w); }
        const float rstd = 1.f / sqrtf(wave_sum(s) * (1.f / D) + RMS_EPS); float s2 = 0.f;
#pragma unroll
        for (int j = 0; j < 4; ++j) { const f32x4 g = gp[64 * j]; x[j] = x[j] + y[j] * rstd * g; xo[64 * j] = x[j]; s2 += (x[j].x * x[j].x + x[j].y * x[j].y) + (x[j].z * x[j].z + x[j].w * x[j].w); }
        if (layer + 1 < DEPTH) {
            const float r2 = 1.f / sqrtf(wave_sum(s2) * (1.f / D) + RMS_EPS);
            GAS unsigned long long* o8 = (GAS unsigned long long*)(F.XN() + (size_t)m * D) + lane;
#pragma unroll
            for (int j = 0; j < 4; ++j) { const f32x4 g = gn[64 * j];
                o8[64 * j] = (unsigned long long)pk2(x[j].x * r2 * g.x, x[j].y * r2 * g.y) | ((unsigned long long)pk2(x[j].z * r2 * g.z, x[j].w * r2 * g.w) << 32); }
        }
    }
}

__device__ __forceinline__ float silu_f(float z) { return z / (1.f + __expf(-z)); }
__device__ __forceinline__ int t5_bucket(int rel) {
    const int n = rel < 0 ? -rel : rel;
    const int lg = 8 + (n >= 12) + (n >= 16) + (n >= 23) + (n >= 32) + (n >= 46) + (n >= 64) + (n >= 91);
    return (rel > 0 ? 16 : 0) + (n < 8 ? n : lg);
}
__device__ __forceinline__ void attn_simple(Frame& F, const Args& A, LAS float* scr, const LAS float* T5, const LAS float* CR, int lane, int KIND,
        int qrow, int qcol, int h, int qpos, bool writer,
        int nct, const float* cK, const float* cV, int cstride,
        int npt, int prow0, int kcol, int vcol,
        int kpos0,
        float sink, bool has_sink, int zcol, int ycol) {
    LAS float* Kl = scr; LAS float* Vl = scr + 2048;
    float q[64], o[64];
    { const bf16* qp = F.P() + (size_t)qrow * NIN + qcol;
#pragma unroll
      for (int d8 = 0; d8 < 8; ++d8) { const v4u w = *(const GAS v4u*)(qp + 8 * d8);
          q[8 * d8 + 0] = __builtin_bit_cast(float, w.x << 16) * 0.125f; q[8 * d8 + 1] = __builtin_bit_cast(float, w.x & 0xffff0000u) * 0.125f;
          q[8 * d8 + 2] = __builtin_bit_cast(float, w.y << 16) * 0.125f; q[8 * d8 + 3] = __builtin_bit_cast(float, w.y & 0xffff0000u) * 0.125f;
          q[8 * d8 + 4] = __builtin_bit_cast(float, w.z << 16) * 0.125f; q[8 * d8 + 5] = __builtin_bit_cast(float, w.z & 0xffff0000u) * 0.125f;
          q[8 * d8 + 6] = __builtin_bit_cast(float, w.w << 16) * 0.125f; q[8 * d8 + 7] = __builtin_bit_cast(float, w.w & 0xffff0000u) * 0.125f; } }
#pragma unroll
    for (int d = 0; d < 64; ++d) o[d] = 0.f;
    float mrun = has_sink ? sink : -1e30f, lrun = has_sink ? 1.f : 0.f;
    const int nt = nct + npt;
    for (int t = 0; t < nt; ++t) {
        asm volatile("s_waitcnt lgkmcnt(0)" ::: "memory");
        if (t < nct) { const float* kp = cK + (size_t)(t * 32) * cstride + lane; const float* vp = cV + (size_t)(t * 32) * cstride + lane;
#pragma unroll 4
            for (int e = 0; e < 32; ++e) { Kl[e * 64 + lane] = kp[(size_t)e * cstride]; Vl[e * 64 + lane] = vp[(size_t)e * cstride]; }
        } else { const bf16* kp = F.P() + (size_t)(prow0 + (t - nct) * 32) * NIN + lane;
#pragma unroll 4
            for (int e = 0; e < 32; ++e) { Kl[e * 64 + lane] = bf2f(kp[(size_t)e * NIN + kcol]); Vl[e * 64 + lane] = bf2f(kp[(size_t)e * NIN + vcol]); }
        }
        asm volatile("s_waitcnt vmcnt(0) lgkmcnt(0)" ::: "memory");
        const int relb = kpos0 + t * 32 - qpos;
#pragma unroll 1
        for (int jj = 0; jj < 32; ++jj) {
            const LAS f32x4* k4 = (const LAS f32x4*)(Kl + jj * 64);
            float s0 = 0.f, s1 = 0.f;
#pragma unroll
            for (int d4 = 0; d4 < 16; d4 += 2) { const f32x4 a = k4[d4], b = k4[d4 + 1];
                s0 += q[4 * d4] * a.x + q[4 * d4 + 1] * a.y + q[4 * d4 + 2] * a.z + q[4 * d4 + 3] * a.w;
                s1 += q[4 * d4 + 4] * b.x + q[4 * d4 + 5] * b.y + q[4 * d4 + 6] * b.z + q[4 * d4 + 7] * b.w;
                if ((d4 & 3) == 2) asm volatile("" ::: "memory"); }
            const int rel = relb + jj;
            float bias;
            if (KIND == 0) bias = T5[t5_bucket(rel) * 8 + h];
            else { const int ci = (rel < -128 ? -128 : (rel > 128 ? 128 : rel)) + 128; bias = CR[ci * 4 + h]; }
            const float s = s0 + s1 + bias;
            if (s > mrun) { const float sc = __expf(mrun - s); lrun *= sc;
#pragma unroll
                for (int d = 0; d < 64; ++d) o[d] *= sc;
                mrun = s; }
            const float p = __expf(s - mrun); lrun += p;
            const LAS f32x4* v4 = (const LAS f32x4*)(Vl + jj * 64);
#pragma unroll
            for (int d4 = 0; d4 < 16; ++d4) { const f32x4 a = v4[d4]; o[4 * d4] += p * a.x; o[4 * d4 + 1] += p * a.y; o[4 * d4 + 2] += p * a.z; o[4 * d4 + 3] += p * a.w;
                if ((d4 & 3) == 3) asm volatile("" ::: "memory"); }
        }
    }
    const float inv = 1.f / lrun;
    if (writer) { const bf16* zp = F.P() + (size_t)qrow * NIN + zcol; bf16* yp = F.Y() + (size_t)qrow * D + ycol;
#pragma unroll
        for (int d8 = 0; d8 < 8; ++d8) { const v4u w = *(const GAS v4u*)(zp + 8 * d8); float z[8];
            z[0] = __builtin_bit_cast(float, w.x << 16); z[1] = __builtin_bit_cast(float, w.x & 0xffff0000u); z[2] = __builtin_bit_cast(float, w.y << 16); z[3] = __builtin_bit_cast(float, w.y & 0xffff0000u);
            z[4] = __builtin_bit_cast(float, w.z << 16); z[5] = __builtin_bit_cast(float, w.z & 0xffff0000u); z[6] = __builtin_bit_cast(float, w.w << 16); z[7] = __builtin_bit_cast(float, w.w & 0xffff0000u);
            v4u r; r.x = pk2(o[8 * d8] * inv * silu_f(z[0]), o[8 * d8 + 1] * inv * silu_f(z[1])); r.y = pk2(o[8 * d8 + 2] * inv * silu_f(z[2]), o[8 * d8 + 3] * inv * silu_f(z[3]));
            r.z = pk2(o[8 * d8 + 4] * inv * silu_f(z[4]), o[8 * d8 + 5] * inv * silu_f(z[5])); r.w = pk2(o[8 * d8 + 6] * inv * silu_f(z[6]), o[8 * d8 + 7] * inv * silu_f(z[7]));
            *(GAS v4u*)(yp + 8 * d8) = r; } }
}

__device__ __forceinline__ void mixa_simple(Frame& F, const Args& A, LAS float* scr, int lane, int layer, int T, int row0, int g, float* avs_out  ) {
    constexpr int TM = 128;
    LAS float* rs = scr;
    LAS float* wr = scr + 128;
    const int c = g * 64 + lane;
    for (int s = 0; s < T; ++s) {
        const unsigned long long w = *(const GAS unsigned long long*)(F.P() + (size_t)(row0 + s) * NIN + PC_AV + 4 * lane);
        const float a = __builtin_bit_cast(float, (unsigned)w << 16), b = __builtin_bit_cast(float, (unsigned)w & 0xffff0000u), cc = __builtin_bit_cast(float, (unsigned)(w >> 32) << 16), dd = __builtin_bit_cast(float, (unsigned)(w >> 32) & 0xffff0000u);
        const float ss = wave_sum((a * a + b * b) + (cc * cc + dd * dd));
        if (lane == 0) rs[s] = 1.f / sqrtf(ss * (1.f / 256.f) + RMS_EPS);
    }
    asm volatile("s_waitcnt lgkmcnt(0)" ::: "memory");
    const float ga = A.in[10][(size_t)layer * 256 + c];
    float vn[TM];
    { const bf16* vp = F.P() + (size_t)row0 * NIN + PC_AV + c;
#pragma unroll
      for (int s8 = 0; s8 < TM; s8 += 8) {
          if (s8 < T) {
#pragma unroll
              for (int s = s8; s < s8 + 8; ++s) vn[s] = bf2f(vp[(size_t)(s - s8) * NIN]) * rs[s] * ga;
              if (avs_out) {
#pragma unroll
                  for (int s = s8; s < s8 + 8; ++s) avs_out[(size_t)s * 256 + c] = vn[s];
              }
          } else {
#pragma unroll
              for (int s = s8; s < s8 + 8; ++s) vn[s] = 0.f;
          }
          vp += 8 * NIN; asm volatile("" : "+v"(vp) :: "memory"); } }
    const float* Wg = A.in[11] + ((size_t)layer * 4 + g) * 128 * 128; const float* bsg = A.in[12] + ((size_t)layer * 4 + g) * 128;
    for (int t = 0; t < T; ++t) {
        asm volatile("s_waitcnt lgkmcnt(0)" ::: "memory");
        for (int s = lane; s < TM; s += 64) wr[s] = (s <= t) ? Wg[(size_t)t * 128 + s] : 0.f;
        asm volatile("s_waitcnt vmcnt(0) lgkmcnt(0)" ::: "memory");
        float a0 = bsg[t], a1 = 0.f;
        const LAS f32x4* w4 = (const LAS f32x4*)wr;
#pragma unroll
        for (int s4 = 0; s4 < TM / 4; s4 += 2) { const f32x4 a = w4[s4], b = w4[s4 + 1];
            a0 += a.x * vn[4 * s4] + a.y * vn[4 * s4 + 1] + a.z * vn[4 * s4 + 2] + a.w * vn[4 * s4 + 3];
            a1 += b.x * vn[4 * s4 + 4] + b.y * vn[4 * s4 + 5] + b.z * vn[4 * s4 + 6] + b.w * vn[4 * s4 + 7];
            if ((s4 & 7) == 6) asm volatile("" ::: "memory"); }
        const bf16* pr = F.P() + (size_t)(row0 + t) * NIN;
        const float y = bf2f(pr[PC_AU + c]) * (a0 + a1) * silu_f(bf2f(pr[PC_AZ + c]));
        F.Y()[(size_t)(row0 + t) * D + YC_A + c] = (bf16)f2bf(y);
    }
}

constexpr int U_AP = 8 * 16 * 4, U_AS = 32 * 4, U_BP = 8 * 32 * 8, U_BS = 32 * 2 * 2, U_CP = 8 * 32 * 4, U_CS = 32 * 4;
constexpr int U_ATT = U_CP + U_BP + U_CS + U_BS, U_TOTAL = U_ATT + U_AP + U_AS;
template <int NW>
__device__ __forceinline__ void mix_phase_simple(Frame& F, const Args& A, int layer) {
    { LAS float* T5 = (LAS float*)(F.lds + NW * 16384); LAS float* CR = (LAS float*)(F.lds + NW * 16384 + 1024);
      for (int i = F.tid; i < 256; i += NW * 64) T5[i] = A.in[15][i];
      for (int i = F.tid; i < 257 * 4; i += NW * 64) CR[i] = A.in[14][(size_t)layer * 257 * 4 + i];
      __syncthreads(); }
    LAS float* scr = (LAS float*)(F.lds + RING_OFF + F.wave * 16384);
    const int gw = F.vcu * NW + F.wave, NGW = F.G * NW; const int lane = F.lane;
    for (int u0 = gw; u0 < U_TOTAL; u0 += NGW) {
        int u = u0;
        if (u < U_ATT) {
            int kind, qrow, qcol, h, qpos, nct = 0, cstride = 0, npt, prow0, kcol, vcol, kpos0, zcol, ycol; bool writer = true, has_sink; float sink = 0.f; const float* cK = nullptr; const float* cV = nullptr;
            if (u < U_CP) { h = u & 3; const int n = (u >> 2) & 31, b = u >> 7; const int c0 = n >= 8 ? n - 8 : 0; qrow = b * SEQ + n * 64 + lane;
                kind = 1; qcol = PC_CQ + h * 64; qpos = qrow; npt = 2 * (n + 1 - c0); prow0 = b * SEQ + c0 * 64; kcol = PC_CK + h * 64; vcol = PC_CV + h * 64; kpos0 = prow0; has_sink = false; zcol = PC_CZ + h * 64; ycol = YC_C + h * 64; }
            else if (u < U_CP + U_BP) { u -= U_CP; h = u & 7; const int n = (u >> 3) & 31, b = u >> 8; const int c0 = n >= 2 ? n - 2 : 0; qrow = b * SEQ + n * 64 + lane; const int kvh = h >> 2;
                kind = 0; qcol = PC_BQ + h * 64; qpos = qrow; npt = 2 * (n + 1 - c0); prow0 = b * SEQ + c0 * 64; kcol = PC_BK + kvh * 64; vcol = PC_BV + kvh * 64; kpos0 = prow0; has_sink = true; zcol = PC_BZ + h * 64; ycol = YC_B + h * 64; }
            else if (u < U_CP + U_BP + U_CS) { u -= U_CP + U_BP; h = u & 3; const int s = u >> 2; const int i = lane & 31; qrow = NPROMPT + s * 32 + i;
                cK = A.in[4] + ((size_t)(layer * 32 + s) * 512) * 256 + h * 64; cV = A.in[5] + ((size_t)(layer * 32 + s) * 512) * 256 + h * 64;
                kind = 1; qcol = PC_CQ + h * 64; qpos = i; writer = lane < 32; nct = 16; cstride = 256; npt = 1; prow0 = NPROMPT + s * 32; kcol = PC_CK + h * 64; vcol = PC_CV + h * 64; kpos0 = -512; has_sink = false; zcol = PC_CZ + h * 64; ycol = YC_C + h * 64; }
            else { u -= U_CP + U_BP + U_CS; const int gp = u & 1, kvh = (u >> 1) & 1, s = u >> 2; const int i = lane & 31; h = kvh * 4 + gp * 2 + (lane >> 5); qrow = NPROMPT + s * 32 + i;
                cK = A.in[2] + ((size_t)(layer * 32 + s) * 128) * 128 + kvh * 64; cV = A.in[3] + ((size_t)(layer * 32 + s) * 128) * 128 + kvh * 64;
                kind = 0; qcol = PC_BQ + h * 64; qpos = i; nct = 4; cstride = 128; npt = 1; prow0 = NPROMPT + s * 32; kcol = PC_BK + kvh * 64; vcol = PC_BV + kvh * 64; kpos0 = -128; has_sink = true; zcol = PC_BZ + h * 64; ycol = YC_B + h * 64; }
            if (has_sink) sink = A.in[13][layer * 8 + h];
            attn_simple(F, A, scr, (const LAS float*)(F.lds + NW * 16384), (const LAS float*)(F.lds + NW * 16384 + 1024), lane, kind, qrow, qcol, h, qpos, writer, nct, cK, cV, cstride, npt, prow0, kcol, vcol, kpos0, sink, has_sink, zcol, ycol);
        } else {
            u -= U_ATT;
            int T, row0, g; float* avs = nullptr;
            if (u < U_AP) { g = u & 3; const int n = (u >> 2) & 15, b = u >> 6; T = 128; row0 = b * SEQ + n * 128; }
            else { u -= U_AP; g = u & 3; const int s = u >> 2; T = 32; row0 = NPROMPT + s * 32; avs = F.out + O_AVS + ((size_t)layer * NSAMP + s * 32) * 256; }
            mixa_simple(F, A, scr, lane, layer, T, row0, g, avs);
        }
    }
}


namespace mx {
typedef float f32x16 __attribute__((ext_vector_type(16)));
typedef float f32x2 __attribute__((ext_vector_type(2)));
typedef short s16x4 __attribute__((ext_vector_type(4)));
typedef unsigned u32x2 __attribute__((ext_vector_type(2)));
typedef __bf16 bf16x2_t __attribute__((ext_vector_type(2)));
constexpr float LOG2E = 1.4426950408889634f;
constexpr int TABW = 264;
__device__ __forceinline__ int crow(int r, int hi) { return (r & 3) + 8 * (r >> 2) + 4 * hi; }
__device__ __forceinline__ unsigned cvtpk(float lo, float hi) { f32x2 v = {lo, hi}; bf16x2_t b = __builtin_convertvector(v, bf16x2_t); return __builtin_bit_cast(unsigned, b); }
__device__ __forceinline__ s16x4 vtr(const LAS unsigned char* p) { typedef short v4i16_t __attribute__((ext_vector_type(4))); return __builtin_bit_cast(s16x4, __builtin_amdgcn_ds_read_tr16_b64_v4i16((LAS v4i16_t*)p)); }
__device__ __forceinline__ float silu(float z) { return z * __builtin_amdgcn_rcpf(1.f + __builtin_amdgcn_exp2f(-z * LOG2E)); }
__device__ __forceinline__ float u2f(unsigned u) { return __builtin_bit_cast(float, u); }
__device__ __forceinline__ float bfl(unsigned w) { return __builtin_bit_cast(float, w << 16); }
__device__ __forceinline__ float bfh(unsigned w) { return __builtin_bit_cast(float, w & 0xffff0000u); }

__device__ __forceinline__ void pv_tile(f32x16 (&o)[2], const LAS unsigned char* vb, const v4u (&pw)[4]) {
#pragma unroll
    for (int d0 = 0; d0 < 2; ++d0)
#pragma unroll
        for (int ks = 0; ks < 4; ++ks) {
            const s16x4 lo = vtr(vb + d0 * 4096 + ks * 1024), hi = vtr(vb + d0 * 4096 + ks * 1024 + 512);
            const bf16x8 vf = (bf16x8){lo[0], lo[1], lo[2], lo[3], hi[0], hi[1], hi[2], hi[3]};
            o[d0] = __builtin_amdgcn_mfma_f32_32x32x16_bf16(__builtin_bit_cast(bf16x8, pw[ks]), vf, o[d0], 0, 0, 0);
        }
}

__device__ __forceinline__ void attn_tile(f32x16 (&o)[2], float& m, float& l, const bf16x8 (&qr)[4], f32x16 p0, f32x16 p1,
                                          const LAS unsigned char* Kimg, const LAS unsigned char* Vimg, LAS float* wsf, int r32, int hi) {
    const LAS unsigned char* kb = Kimg + hi * 1024 + r32 * 16;
#pragma unroll
    for (int d0 = 0; d0 < 4; ++d0) {
        const bf16x8 k0 = *(const LAS bf16x8*)(kb + d0 * 2048), k1 = *(const LAS bf16x8*)(kb + d0 * 2048 + 512);
        p0 = __builtin_amdgcn_mfma_f32_32x32x16_bf16(k0, qr[d0], p0, 0, 0, 0);
        p1 = __builtin_amdgcn_mfma_f32_32x32x16_bf16(k1, qr[d0], p1, 0, 0, 0);
    }
    float mt = fmaxf(p0[0], p1[0]);
#pragma unroll
    for (int r = 1; r < 16; ++r) mt = fmaxf(mt, fmaxf(p0[r], p1[r]));
    mt = fmaxf(mt, __shfl_xor(mt, 32));
    if (__any(mt > m)) {
        const float mn = fmaxf(m, mt);
        const float f = __builtin_amdgcn_exp2f((m - mn) * LOG2E);
        m = mn; l *= f;
        if (hi == 0) wsf[r32] = f;
        asm volatile("s_waitcnt lgkmcnt(0)" ::: "memory");
#pragma unroll
        for (int rg = 0; rg < 4; ++rg) { const f32x4 fv = *(const LAS f32x4*)(wsf + 8 * rg + 4 * hi);
#pragma unroll
            for (int e = 0; e < 4; ++e) { o[0][4 * rg + e] *= fv[e]; o[1][4 * rg + e] *= fv[e]; } }
        asm volatile("s_waitcnt lgkmcnt(0)" ::: "memory");
    }
    const float nm = -m * LOG2E;
    float rs = 0.f;
#pragma unroll
    for (int r = 0; r < 16; ++r) { p0[r] = __builtin_amdgcn_exp2f(fmaf(p0[r], LOG2E, nm)); p1[r] = __builtin_amdgcn_exp2f(fmaf(p1[r], LOG2E, nm)); rs += p0[r] + p1[r]; }
    l += rs;
    v4u pw[4];
    pw[0] = (v4u){cvtpk(p0[0], p0[1]), cvtpk(p0[2], p0[3]), cvtpk(p0[4], p0[5]), cvtpk(p0[6], p0[7])};
    pw[1] = (v4u){cvtpk(p0[8], p0[9]), cvtpk(p0[10], p0[11]), cvtpk(p0[12], p0[13]), cvtpk(p0[14], p0[15])};
    pw[2] = (v4u){cvtpk(p1[0], p1[1]), cvtpk(p1[2], p1[3]), cvtpk(p1[4], p1[5]), cvtpk(p1[6], p1[7])};
    pw[3] = (v4u){cvtpk(p1[8], p1[9]), cvtpk(p1[10], p1[11]), cvtpk(p1[12], p1[13]), cvtpk(p1[14], p1[15])};
    const LAS unsigned char* vb = Vimg + ((r32 >> 4) & 1) * 32 + (r32 & 3) * 8 + (4 * hi + ((r32 & 15) >> 2)) * 64;
    pv_tile(o, vb, pw);
}

__device__ __forceinline__ void tile_load(v4u (&t)[4], const bf16* P, int row0, int col0, int lane) {
    const bf16* p = P + (size_t)(row0 + (lane >> 3)) * NIN + col0 + (lane & 7) * 8;
#pragma unroll
    for (int i = 0; i < 4; ++i) t[i] = *(const GAS v4u*)(p + (size_t)i * 8 * NIN);
}
__device__ __forceinline__ void tile_to_elems(unsigned (&e)[16], const v4u (&t)[4], LAS unsigned char* stg, int lane, int r32, int hi) {
#pragma unroll
    for (int i = 0; i < 4; ++i) *(LAS v4u*)(stg + (i * 8 + (lane >> 3)) * 128 + (lane & 7) * 16) = t[i];
    asm volatile("s_waitcnt lgkmcnt(0)" ::: "memory");
#pragma unroll
    for (int r = 0; r < 16; ++r) { const LAS unsigned short* q = (const LAS unsigned short*)(stg + crow(r, hi) * 128) + r32; e[r] = (unsigned)q[0] | ((unsigned)q[32] << 16); }
    asm volatile("s_waitcnt lgkmcnt(0)" ::: "memory");
}
template <bool HAS_U>
__device__ __forceinline__ void wave_epilogue(const f32x16 (&o)[2], bool use_scale, float scale_q, LAS float* wsf, LAS unsigned char* stg, const unsigned (&ze)[16], const unsigned (&ue)[16], bf16* Y, int row0, int ycol, int lane, int r32, int hi) {
    f32x4 sc[4];
    if (use_scale) {
        if (hi == 0) wsf[r32] = scale_q;
        asm volatile("s_waitcnt lgkmcnt(0)" ::: "memory");
#pragma unroll
        for (int rg = 0; rg < 4; ++rg) sc[rg] = *(const LAS f32x4*)(wsf + 8 * rg + 4 * hi);
        asm volatile("s_waitcnt lgkmcnt(0)" ::: "memory");
    } else {
#pragma unroll
        for (int rg = 0; rg < 4; ++rg) sc[rg] = (f32x4){1.f, 1.f, 1.f, 1.f};
    }
#pragma unroll
    for (int r = 0; r < 16; ++r) {
        float v0 = o[0][r] * sc[r >> 2][r & 3] * silu(bfl(ze[r])), v1 = o[1][r] * sc[r >> 2][r & 3] * silu(bfh(ze[r]));
        if (HAS_U) { v0 *= bfl(ue[r]); v1 *= bfh(ue[r]); }
        LAS unsigned short* q = (LAS unsigned short*)(stg + crow(r, hi) * 128) + r32;
        q[0] = (unsigned short)f2bf(v0); q[32] = (unsigned short)f2bf(v1);
    }
    asm volatile("s_waitcnt lgkmcnt(0)" ::: "memory");
    bf16* yp = Y + (size_t)(row0 + (lane >> 3)) * D + ycol + (lane & 7) * 8;
#pragma unroll
    for (int i = 0; i < 4; ++i) { const v4u v = *(const LAS v4u*)(stg + (i * 8 + (lane >> 3)) * 128 + (lane & 7) * 16); *(GAS v4u*)(yp + (size_t)i * 8 * D) = v; }
    asm volatile("s_waitcnt lgkmcnt(0)" ::: "memory");
}

struct AttnUnit {
    int kind;
    int np;
    int T;
    int nct;
    const float* cK; const float* cV; int cpitch;
    int prow0;
    int kcol, vcol;
    int last_valid;
    int dc0;
    bool active; int plane, qrow0, qcol, h, qi0, zcol, ycol; float sink;
};

#define MX_PREFETCH(t_) do { const int t__ = (t_); const int nvalid__ = (t__ == U.T - 1) ? U.last_valid : 64; \
    if (t__ < U.nct) { const float* kp__ = U.cK + (size_t)(t__ * 64 + kkey) * U.cpitch + kd; const float* vp__ = U.cV + (size_t)(t__ * 64 + vkey) * U.cpitch + vd; \
        _Pragma("unroll") for (int p = 0; p < 2; ++p) if (p < U.np) { \
            pre[2 * p][0] = *(const GAS v4u*)(kp__ + 64 * p); pre[2 * p + 1][0] = *(const GAS v4u*)(kp__ + 64 * p + 4); \
            pre[2 * p][1] = *(const GAS v4u*)(vp__ + 64 * p); pre[2 * p + 1][1] = *(const GAS v4u*)(vp__ + 64 * p + 4); } \
    } else { const int pr__ = U.prow0 + (t__ - U.nct) * 64; \
        const bf16* kp__ = F.P() + (size_t)(pr__ + kkey) * NIN + U.kcol + kd; const bf16* vp__ = F.P() + (size_t)(pr__ + vkey) * NIN + U.vcol + vd; \
        _Pragma("unroll") for (int p = 0; p < 4; ++p) if (p < U.np) { \
            pre[p][0] = (kkey < nvalid__) ? *(const GAS v4u*)(kp__ + 64 * p) : (v4u){0u, 0u, 0u, 0u}; \
            pre[p][1] = (vkey < nvalid__) ? *(const GAS v4u*)(vp__ + 64 * p) : (v4u){0u, 0u, 0u, 0u}; } } } while (0)
#define MX_STAGE(t_) do { const int t__ = (t_); LAS unsigned char* dst__ = kv + w * 1024 + lane * 16; \
    if (t__ < U.nct) { \
        _Pragma("unroll") for (int p = 0; p < 2; ++p) if (p < U.np) { \
            _Pragma("unroll") for (int x = 0; x < 2; ++x) { const v4u a = pre[2 * p][x], b = pre[2 * p + 1][x]; v4u o_; \
                o_.x = cvtpk(u2f(a.x), u2f(a.y)); o_.y = cvtpk(u2f(a.z), u2f(a.w)); \
                o_.z = cvtpk(u2f(b.x), u2f(b.y)); o_.w = cvtpk(u2f(b.z), u2f(b.w)); \
                *(LAS v4u*)(dst__ + p * 16384 + x * 8192) = o_; } } \
    } else { \
        _Pragma("unroll") for (int p = 0; p < 4; ++p) if (p < U.np) { *(LAS v4u*)(dst__ + p * 16384) = pre[p][0]; *(LAS v4u*)(dst__ + p * 16384 + 8192) = pre[p][1]; } } } while (0)

__device__ __forceinline__ void attn_unit(Frame& F, const AttnUnit& U, LAS unsigned char* kv, const LAS float* tabB, const LAS float* tabC, float cconst  ) {
    const int lane = F.lane, w = F.wave, r32 = lane & 31, hi = lane >> 5;
    LAS float* wsf = (LAS float*)(F.lds + WSF_OFF) + w * 64;
    LAS unsigned char* stg = F.lds + STG_OFF + w * 4096;
    v4u zt[4];
    v4u pre[4][2];
    const int kkey = lane, vkey = 16 * (w & 3) + (lane >> 2);
    const int kd = 8 * w, vd = (w >> 2) * 32 + (lane & 3) * 8;
    bf16x8 qr[4]; f32x16 o[2]; float m, l;
    o[0] = (f32x16){}; o[1] = (f32x16){};
    const int qi = U.qi0 + r32;
    if (U.active) {
        tile_load(zt, F.P(), U.qrow0, U.zcol, lane);
        const bf16* qp = F.P() + (size_t)(U.qrow0 + r32) * NIN + U.qcol + 8 * hi;
#pragma unroll
        for (int d0 = 0; d0 < 4; ++d0) { const v4u x = *(const GAS v4u*)(qp + 16 * d0);
            v4u y; y.x = cvtpk(bfl(x.x) * 0.125f, bfh(x.x) * 0.125f); y.y = cvtpk(bfl(x.y) * 0.125f, bfh(x.y) * 0.125f); y.z = cvtpk(bfl(x.z) * 0.125f, bfh(x.z) * 0.125f); y.w = cvtpk(bfl(x.w) * 0.125f, bfh(x.w) * 0.125f);
            qr[d0] = __builtin_bit_cast(bf16x8, y); }
    } else {
#pragma unroll
        for (int d0 = 0; d0 < 4; ++d0) qr[d0] = (bf16x8){};
#pragma unroll
        for (int i = 0; i < 4; ++i) zt[i] = (v4u){0u, 0u, 0u, 0u};
    }
    if (U.kind == 0) { m = U.sink; l = (hi == 0) ? 1.f : 0.f; } else { m = -1e30f; l = 0.f; }
    const int cp = (qi + 1) & 1;
    const LAS float* ltab = (U.kind == 0 ? tabB : tabC) + (U.h * 2 + cp) * TABW + (191 - qi + 4 * hi + cp);
    MX_PREFETCH(0);
    for (int t = 0; t < U.T; ++t) {
        __syncthreads();
        MX_STAGE(t);
        __syncthreads();
        if (t + 1 < U.T) MX_PREFETCH(t + 1);
        if (U.active) {
            const int dc = U.dc0 + t;
            f32x16 p0, p1;
            if (dc >= -2) {
                const LAS float* tp = ltab + dc * 64;
#pragma unroll
                for (int rg = 0; rg < 4; ++rg)
#pragma unroll
                    for (int pp = 0; pp < 2; ++pp) { const f32x2 a = *(const LAS f32x2*)(tp + 8 * rg + 2 * pp), b = *(const LAS f32x2*)(tp + 32 + 8 * rg + 2 * pp);
                        p0[4 * rg + 2 * pp] = a.x; p0[4 * rg + 2 * pp + 1] = a.y; p1[4 * rg + 2 * pp] = b.x; p1[4 * rg + 2 * pp + 1] = b.y; }
            } else {
#pragma unroll
                for (int r = 0; r < 16; ++r) { p0[r] = cconst; p1[r] = cconst; }
            }
            if (t == U.T - 1 && U.last_valid == 32) {
#pragma unroll
                for (int r = 0; r < 16; ++r) p1[r] = -1e30f;
            }
            attn_tile(o, m, l, qr, p0, p1, kv + U.plane * 16384, kv + U.plane * 16384 + 8192, wsf, r32, hi);
        }
    }
    if (U.active) {
        l += __shfl_xor(l, 32);
        unsigned ze[16]; tile_to_elems(ze, zt, stg, lane, r32, hi);
        wave_epilogue<false>(o, true, 1.f / l, wsf, stg, ze, ze, F.Y(), U.qrow0, U.ycol, lane, r32, hi);
    }
}

__device__ __forceinline__ void mixa_unit(Frame& F, const Args& A, int layer, int row0, int T, float* avs  , LAS unsigned char* kv) {
    const int lane = F.lane, w = F.wave, r32 = lane & 31, hi = lane >> 5;
    __syncthreads();
    {
        const f32x4 ga = *(const GAS f32x4*)(A.in[10] + (size_t)layer * 256 + 4 * lane);
        const int g = lane >> 4, cg = 4 * (lane & 15);
        const int TS = T < 64 ? 64 : T;
        u32x2 xr[16];
#pragma unroll
        for (int k = 0; k < 16; ++k) { const int s = w + 8 * k; xr[k] = (s < T) ? *(const GAS u32x2*)(F.P() + (size_t)(row0 + s) * NIN + PC_AV + 4 * lane) : (u32x2){0u, 0u}; }
#pragma unroll
        for (int k = 0; k < 16; ++k) {
            const int s = w + 8 * k;
            if (s < TS) {
                LAS u32x2* dst = (LAS u32x2*)(kv + g * 16384 + (s >> 6) * 8192 + (cg >> 5) * 4096 + (s & 63) * 64 + (cg & 31) * 2);
                if (s < T) {
                    const u32x2 x = xr[k];
                    float a = bfl(x.x), b = bfh(x.x), c = bfl(x.y), d = bfh(x.y);
                    const float rstd = 1.f / sqrtf(wave_sum((a * a + b * b) + (c * c + d * d)) * (1.f / 256.f) + RMS_EPS);
                    a *= rstd * ga.x; b *= rstd * ga.y; c *= rstd * ga.z; d *= rstd * ga.w;
                    if (avs) *(GAS f32x4*)(avs + (size_t)s * 256 + 4 * lane) = (f32x4){a, b, c, d};
                    *dst = (u32x2){cvtpk(a, b), cvtpk(c, d)};
                } else *dst = (u32x2){0u, 0u};
            }
        }
    }
    __syncthreads();
    const int g = w >> 1;
    const bf16* Wg = F.Wtril() + (size_t)(layer * 4 + g) * 128 * 128;
    const float* bsg = A.in[12] + (size_t)(layer * 4 + g) * 128;
    for (int i = 0; i < 2; ++i) {
        const int tb = 2 * (w & 1) + i;
        if (tb * 32 >= T) break;
        f32x16 o[2];
        v4u zt[4], ut[4]; tile_load(zt, F.P(), row0 + tb * 32, PC_AZ + g * 64, lane); tile_load(ut, F.P(), row0 + tb * 32, PC_AU + g * 64, lane);
#pragma unroll
        for (int rg = 0; rg < 4; ++rg) { const f32x4 bv = *(const GAS f32x4*)(bsg + tb * 32 + 8 * rg + 4 * hi);
#pragma unroll
            for (int e = 0; e < 4; ++e) { o[0][4 * rg + e] = bv[e]; o[1][4 * rg + e] = bv[e]; } }
        const int nst = (tb >= 2) ? 2 : 1;
        for (int st = 0; st < nst; ++st) {
            v4u pw[4];
            const bf16* wp = Wg + (size_t)(tb * 32 + r32) * 128 + st * 64 + 4 * hi;
#pragma unroll
            for (int ks = 0; ks < 4; ++ks) { const u32x2 a = *(const GAS u32x2*)(wp + 16 * ks), b = *(const GAS u32x2*)(wp + 16 * ks + 8); pw[ks] = (v4u){a.x, a.y, b.x, b.y}; }
            const LAS unsigned char* vb = kv + g * 16384 + st * 8192 + ((r32 >> 4) & 1) * 32 + (r32 & 3) * 8 + (4 * hi + ((r32 & 15) >> 2)) * 64;
            pv_tile(o, vb, pw);
        }
        LAS unsigned char* stg = F.lds + STG_OFF + w * 4096;
        unsigned ze[16], ue[16]; tile_to_elems(ze, zt, stg, lane, r32, hi); tile_to_elems(ue, ut, stg, lane, r32, hi);
        wave_epilogue<true>(o, false, 1.f, nullptr, stg, ze, ue, F.Y(), row0 + tb * 32, YC_A + g * 64, lane, r32, hi);
    }
}
}

#ifndef MIX_MASK
#define MIX_MASK 63
#endif
#ifndef MIX_REP
#define MIX_REP 0
#endif
constexpr int MU_CP = 256, MU_CS = 128, MU_BS = 32, MU_BP = 512, MU_AP = 128, MU_AS = 32;
constexpr int MU_TOTAL = MU_CP + MU_CS + MU_BS + MU_BP + MU_AP + MU_AS;
__device__ __forceinline__ void mix_phase(Frame& F0, const Args& A, int layer) {
    Frame F = F0;
    { int tid = threadIdx.x; asm volatile("" : "+v"(tid)); F.tid = tid; F.lane = tid & 63; F.wave = __builtin_amdgcn_readfirstlane(tid >> 6); }
    LAS unsigned char* kv = F.lds + KV_OFF;
    LAS float* tabB = (LAS float*)(F.lds + TABB_OFF); LAS float* tabC = (LAS float*)(F.lds + TABC_OFF);
    __syncthreads();
    for (int i = F.tid; i < 8 * 2 * mx::TABW; i += NWAVES * 64) { const int h = i / (2 * mx::TABW), cp = (i / mx::TABW) & 1, rel = (i % mx::TABW) - cp - 191;
        tabB[i] = (rel >= -191 && rel <= 63) ? A.in[15][t5_bucket(rel) * 8 + h] : 0.f; }
    for (int i = F.tid; i < 4 * 2 * mx::TABW; i += NWAVES * 64) { const int h = i / (2 * mx::TABW), cp = (i / mx::TABW) & 1, rel = (i % mx::TABW) - cp - 191;
        const int ci = (rel < -128 ? -128 : (rel > 128 ? 128 : rel)) + 128; tabC[i] = A.in[14][((size_t)layer * 257 + ci) * 4 + h]; }
    __syncthreads();
    const int w = F.wave;
    for (int u0 = F.vcu; u0 < MU_TOTAL; u0 += F.G) {
        int u = u0;
        if (u < MU_CP + MU_CS + MU_BS + MU_BP) {
            mx::AttnUnit U; U.cK = nullptr; U.cV = nullptr; U.cpitch = 0; U.nct = 0; U.last_valid = 64; U.sink = 0.f; float cconst = 0.f;
            int ty;
            if (u < MU_CP) { ty = 0; const int n = 31 - (u >> 3), b = u & 7; const int c0 = n >= 8 ? n - 8 : 0; const int h = w >> 1;
                U.kind = 1; U.np = 4; U.T = n - c0 + 1; U.prow0 = b * SEQ + c0 * 64; U.kcol = PC_CK; U.vcol = PC_CV; U.dc0 = c0 - n;
                U.active = true; U.plane = h; U.qrow0 = b * SEQ + n * 64 + (w & 1) * 32; U.qcol = PC_CQ + h * 64; U.h = h; U.qi0 = (w & 1) * 32; U.zcol = PC_CZ + h * 64; U.ycol = YC_C + h * 64;
                cconst = A.in[14][((size_t)layer * 257) * 4 + h]; }
            else if (u < MU_CP + MU_CS) { ty = 1; u -= MU_CP; const int h = u & 3, s = u >> 2;
                U.kind = 1; U.np = 1; U.T = 9; U.nct = 8; U.cK = A.in[4] + ((size_t)(layer * 32 + s) * 512) * 256 + h * 64; U.cV = A.in[5] + ((size_t)(layer * 32 + s) * 512) * 256 + h * 64; U.cpitch = 256;
                U.prow0 = NPROMPT + s * 32; U.kcol = PC_CK + h * 64; U.vcol = PC_CV + h * 64; U.last_valid = 32; U.dc0 = -8;
                U.active = (w == 0); U.plane = 0; U.qrow0 = NPROMPT + s * 32; U.qcol = PC_CQ + h * 64; U.h = h; U.qi0 = 0; U.zcol = PC_CZ + h * 64; U.ycol = YC_C + h * 64;
                cconst = A.in[14][((size_t)layer * 257) * 4 + h]; }
            else if (u < MU_CP + MU_CS + MU_BS) { ty = 2; u -= MU_CP + MU_CS; const int s = u; const int h = w;
                U.kind = 0; U.np = 2; U.T = 3; U.nct = 2; U.cK = A.in[2] + ((size_t)(layer * 32 + s) * 128) * 128; U.cV = A.in[3] + ((size_t)(layer * 32 + s) * 128) * 128; U.cpitch = 128;
                U.prow0 = NPROMPT + s * 32; U.kcol = PC_BK; U.vcol = PC_BV; U.last_valid = 32; U.dc0 = -2;
                U.active = true; U.plane = h >> 2; U.qrow0 = NPROMPT + s * 32; U.qcol = PC_BQ + h * 64; U.h = h; U.qi0 = 0; U.zcol = PC_BZ + h * 64; U.ycol = YC_B + h * 64; U.sink = A.in[13][layer * 8 + h]; }
            else { ty = 3; u -= MU_CP + MU_CS + MU_BS; const int kvh = u & 1, n = 31 - ((u >> 1) & 31), b = u >> 6; const int c0 = n >= 2 ? n - 2 : 0; const int h = kvh * 4 + (w >> 1);
                U.kind = 0; U.np = 1; U.T = n - c0 + 1; U.prow0 = b * SEQ + c0 * 64; U.kcol = PC_BK + kvh * 64; U.vcol = PC_BV + kvh * 64; U.dc0 = c0 - n;
                U.active = true; U.plane = 0; U.qrow0 = b * SEQ + n * 64 + (w & 1) * 32; U.qcol = PC_BQ + h * 64; U.h = h; U.qi0 = (w & 1) * 32; U.zcol = PC_BZ + h * 64; U.ycol = YC_B + h * 64; U.sink = A.in[13][layer * 8 + h]; }
            if (!((MIX_MASK >> ty) & 1)) continue;
            mx::attn_unit(F, U, kv, tabB, tabC, cconst);
#if MIX_REP
            if ((MIX_REP >> ty) & 1) mx::attn_unit(F, U, kv, tabB, tabC, cconst);
#endif
        } else {
            u -= MU_CP + MU_CS + MU_BS + MU_BP;
            if (u < MU_AP) { if (!((MIX_MASK >> 4) & 1)) continue; const int n = u & 15, b = u >> 4; mx::mixa_unit(F, A, layer, b * SEQ + n * 128, 128, nullptr, kv);
#if MIX_REP
                if ((MIX_REP >> 4) & 1) mx::mixa_unit(F, A, layer, b * SEQ + n * 128, 128, nullptr, kv);
#endif
            }
            else { if (!((MIX_MASK >> 5) & 1)) continue; u -= MU_AP; const int s = u; mx::mixa_unit(F, A, layer, NPROMPT + s * 32, 32, F.out + O_AVS + ((size_t)layer * NSAMP + s * 32) * 256, kv); }
        }
    }
    __syncthreads();
}
constexpr int N_PHASES = 1 + 4 * DEPTH;
__global__ void __launch_bounds__(NWAVES * 64, 2) mk_fwd(Args args) {
    extern __shared__ __attribute__((aligned(16))) unsigned char lds[];
    Frame F;
    F.lds = (LAS unsigned char*)lds;
    F.tid = 0; F.lane = 0; F.wave = 0;
    F.G = gridDim.x; { const int bx = blockIdx.x; F.vcu = (F.G % 8 == 0) ? (bx % 8) * (F.G / 8) + bx / 8 : bx; }
    F.ws = args.ws; F.out = args.out;
    for (int u = threadIdx.x; u < (LDS_BYTES - LDSCTL_OFF) / 4; u += NWAVES * 64) ((LAS unsigned*)(F.lds + LDSCTL_OFF))[u] = 0u;
    __syncthreads();
    const int lo = args.ph_lo, hi = args.ph_hi;
    const bool multi = (hi - lo) > 1;
    XcdBarrier bar; bar.bar = (unsigned*)(F.ws + WS_CTL) + CW_BAR; bar.x = 0; bar.st = nullptr;
    if (multi) bar = xcd_barrier_post((unsigned*)(F.ws + WS_CTL) + CW_BAR, (volatile LAS unsigned*)(F.lds + MISC_OFF) + 8);
#define IN(k) (lo <= (k) && (k) < hi)
#define SEAM(k) do { if (IN(k) && IN((k) + 1)) xcd_barrier(bar); } while (0)
    if (IN(0)) { p0_prologue(F, args); SEAM(0); }
    for (int layer = 0; layer < DEPTH; ++layer) {
        const int p0 = 1 + 4 * layer;
        if (IN(p0)) {
            pg8::Gemm g{F.XN(), F.Win_t() + (size_t)layer * NIN * D, M, NIN, D}; pg8::StaticOrder S; S.init(M, NIN, F.G, (int)blockIdx.x);
            pg8::EpiP E{F.P(), F.out, layer};
            pg8::gemm_phase<pg8::EpiP, pg8::StaticOrder, true, true>(F.lds + RING_OFF, g, S, E);
            SEAM(p0);
        }
        if (IN(p0 + 1)) { mix_phase(F, args, layer); SEAM(p0 + 1); }
        if (IN(p0 + 2)) {
            pg8::Gemm g{F.Y(), F.Wout_t() + (size_t)layer * D * D, M, D, D}; pg8::StaticOrder S; S.init(M, D, F.G, (int)blockIdx.x);
            pg8::EpiF32 E{F.YF(), D};
            pg8::gemm_phase<pg8::EpiF32, pg8::StaticOrder, true, true>(F.lds + RING_OFF, g, S, E);
            SEAM(p0 + 2);
        }
        if (IN(p0 + 3)) { post_phase(F, args, layer); SEAM(p0 + 3); }
    }
#undef IN
#undef SEAM
}

constexpr int MIXK_LDS = 4 * 16384 + 1024 + 4352;
__global__ void __launch_bounds__(256) mix_simple_kernel(Args args, int layer) {
    __shared__ __attribute__((aligned(16))) unsigned char lds_m[MIXK_LDS];
    Frame F;
    F.lds = (LAS unsigned char*)lds_m;
    F.tid = threadIdx.x; F.lane = F.tid & 63; F.wave = __builtin_amdgcn_readfirstlane(F.tid >> 6);
    F.G = gridDim.x; F.vcu = blockIdx.x;
    F.ws = args.ws; F.out = args.out;
    mix_phase_simple<4>(F, args, layer);
}

#ifndef MK_SINGLE
#define MK_SINGLE 1
#endif
extern "C" void kernel_launch(void* const* d_in, const int* in_sizes, int n_in, void* d_out, int out_size, void* d_ws, size_t ws_size, hipStream_t stream) {
    static int grid = 0;
    if (grid == 0) {
        if (n_in != 16 || out_size != (int)O_END || ws_size < WS_END) { fprintf(stderr, "kernel_launch: unexpected shapes: n_in %d out %d ws %zu\n", n_in, out_size, ws_size); grid = -1; return; }
        int dev = 0, cus = 0;
        if (hipGetDevice(&dev) != hipSuccess || hipDeviceGetAttribute(&cus, hipDeviceAttributeMultiprocessorCount, dev) != hipSuccess) { grid = -1; return; }
        if (hipFuncSetAttribute((const void*)mk_fwd, hipFuncAttributeMaxDynamicSharedMemorySize, LDS_BYTES) != hipSuccess) { fprintf(stderr, "kernel_launch: hipFuncSetAttribute failed\n"); grid = -1; return; }
        (void)hipGetLastError();
        grid = cus;
    }
    if (grid < 0) return;
    (void)hipMemsetAsync((char*)d_ws + WS_CTL, 0, CTL_ZERO_BYTES, stream);
    Args a{};
    for (int i = 0; i < 16; ++i) a.in[i] = (const float*)d_in[i];
    a.out = (float*)d_out; a.ws = (unsigned char*)d_ws;
#if MK_SINGLE
    a.ph_lo = 0; a.ph_hi = N_PHASES;
    hipLaunchKernelGGL(mk_fwd, dim3(grid), dim3(NWAVES * 64), LDS_BYTES, stream, a);
#else
    for (int ph = 0; ph < N_PHASES; ++ph) {
#if MIX_MASK != 63
        if (ph >= 1 && ((ph - 1) & 3) == 1) hipLaunchKernelGGL(mix_simple_kernel, dim3(1024), dim3(256), 0, stream, a, (ph - 1) >> 2);
#endif
        a.ph_lo = ph; a.ph_hi = ph + 1; hipLaunchKernelGGL(mk_fwd, dim3(grid), dim3(NWAVES * 64), LDS_BYTES, stream, a); }
#endif
}
```

```cpp
#include <hip/hip_runtime.h>
#include <cstdio>
#include <cstdint>

constexpr int D = 1024, NPROMPT = 8 * 2048, NSAMP = 32 * 32, M = NPROMPT + NSAMP  , NIN = 3072, DEPTH = 4, SEQ = 2048;
constexpr float RMS_EPS = 1e-6f;
constexpr int PC_AU = 0, PC_AV = 256, PC_AZ = 512, PC_BQ = 768, PC_BK = 1280, PC_BV = 1408, PC_BZ = 1536, PC_CQ = 2048, PC_CK = 2304, PC_CV = 2560, PC_CZ = 2816;
constexpr int YC_A = 0, YC_B = 256, YC_C = 768;
constexpr size_t O_YP = 0, O_YS = 16777216, O_BKP = 17825792, O_BVP = 18350080, O_CKP = 18874368, O_CVP = 23068672, O_BKS = 27262976, O_BVS = 27787264, O_CKS = 28311552, O_CVS = 29360128, O_AVS = 30408704, O_END = 31457280;

namespace pg8 {
#define PG8_LAS __attribute__((address_space(3)))
typedef unsigned short bf16_t;
typedef short bf16x8 __attribute__((ext_vector_type(8)));
typedef float f32x4 __attribute__((ext_vector_type(4)));
typedef unsigned u32x4 __attribute__((ext_vector_type(4)));
constexpr int BM = 256, BK = 64, HALF = 128, HTB = HALF * BK * 2  , STAGE_BYTES = 8 * HTB, NXCD = 8, WGM = 8;

__host__ __device__ __forceinline__ int lds_byte(int r, int c) { const int st = (r >> 4) * 2 + (c >> 5), rr = r & 15, cc = c & 31, ob = rr * 64 + cc * 2; return st * 1024 + (ob ^ (((ob >> 9) & 1) << 5)); }
__host__ __device__ __forceinline__ void stage_rc(int b, int& R, int& C) { const int st = b / 1024, sb = b % 1024, swz = sb ^ (((sb >> 9) & 1) << 5); R = (st >> 1) * 16 + swz / 64; C = (st & 1) * 32 + (swz % 64) / 2; }
__host__ __device__ __forceinline__ int perm32(int rho) { const int n = rho >> 4, i = rho & 15; return 8 * (i >> 2) + 4 * n + (i & 3); }

struct Unit { int pm, pn; };
struct Gemm { const bf16_t* A; const bf16_t* Bt; int M, N, K; };

struct StaticOrder {
    int nM, nN, nwg, G, c;
    __host__ __device__ void init(int M, int N, int G_, int c_) { nM = M / BM; nN = N / BM; nwg = nM * nN; G = G_; c = c_; }
    __host__ __device__ bool next(int i, Unit& u) const {
        const long L = (long)i * G + c; if (L >= nwg) return false;
        int wgid = (int)L; { const int q = nwg / NXCD, r = nwg % NXCD, xcd = wgid % NXCD, off = wgid / NXCD; wgid = (xcd < r ? xcd * (q + 1) : r * (q + 1) + (xcd - r) * q) + off; }
        const int nig = WGM * nN, gid = wgid / nig, fm = gid * WGM, gsz = (nM - fm) < WGM ? (nM - fm) : WGM;
        u.pm = fm + ((wgid % nig) % gsz); u.pn = (wgid % nig) / gsz; return true;
    }
    __device__ __forceinline__ void a_ready(const Unit&) const {}
    __device__ __forceinline__ void done(const Unit&) const {}
};


__device__ __forceinline__ unsigned cvt_pk_bf16(float lo, float hi) { unsigned r; asm volatile("v_cvt_pk_bf16_f32 %0, %1, %2" : "=v"(r) : "v"(lo), "v"(hi)); return r; }

struct EpiP {
    static constexpr bool PERM = true, AFTER_DRAIN = false;
    bf16_t* O; float* out; int layer;
    __device__ __forceinline__ void operator()(const f32x4 (&acc)[2][2][4][2], const Unit& u, int wr, int wc, int fr, int fq) const {
        const int row0 = u.pm * BM + wr * 64 + fr; const int col0 = u.pn * BM + wc * 32 + 8 * fq;
#pragma unroll
        for (int ai = 0; ai < 2; ++ai)
#pragma unroll
            for (int m = 0; m < 4; ++m) { bf16_t* rowp = O + (size_t)(row0 + ai * HALF + m * 16) * NIN + col0;
#pragma unroll
                for (int bj = 0; bj < 2; ++bj) { const f32x4 v0 = acc[ai][bj][m][0], v1 = acc[ai][bj][m][1];
                    u32x4 w; w.x = cvt_pk_bf16(v0[0], v0[1]); w.y = cvt_pk_bf16(v0[2], v0[3]); w.z = cvt_pk_bf16(v1[0], v1[1]); w.w = cvt_pk_bf16(v1[2], v1[3]);
                    *(u32x4*)(rowp + bj * HALF) = w; } }
        if (u.pn == 5 || u.pn == 9 || u.pn == 10) {
            const int cc = wc * 32 + 8 * fq;
#pragma unroll
            for (int ai = 0; ai < 2; ++ai)
#pragma unroll
                for (int m = 0; m < 4; ++m) {
                    const int r = row0 + ai * HALF + m * 16;
                    float* d0 = nullptr; float* d1 = nullptr;
                    if (u.pn == 5) {
                        if (r >= NPROMPT) { const size_t o = ((size_t)layer * NSAMP + (r - NPROMPT)) * 128 + cc; d0 = out + O_BKS + o; d1 = out + O_BVS + o; }
                        else { const int t = r & (SEQ - 1), b = r >> 11; if (t >= SEQ - 128) { const size_t o = (((size_t)layer * 8 + b) * 128 + (t - (SEQ - 128))) * 128 + cc; d0 = out + O_BKP + o; d1 = out + O_BVP + o; } }
                    } else {
                        const size_t os = (u.pn == 9) ? O_CKS : O_CVS, op = (u.pn == 9) ? O_CKP : O_CVP;
                        if (r >= NPROMPT) { const size_t o = ((size_t)layer * NSAMP + (r - NPROMPT)) * 256 + cc; d0 = out + os + o; d1 = d0 + 128; }
                        else { const int t = r & (SEQ - 1), b = r >> 11; if (t >= SEQ - 512) { const size_t o = (((size_t)layer * 8 + b) * 512 + (t - (SEQ - 512))) * 256 + cc; d0 = out + op + o; d1 = d0 + 128; } }
                    }
                    if (d0) { *(f32x4*)(d0) = acc[ai][0][m][0]; *(f32x4*)(d0 + 4) = acc[ai][0][m][1]; *(f32x4*)(d1) = acc[ai][1][m][0]; *(f32x4*)(d1 + 4) = acc[ai][1][m][1]; }
                }
        }
    }
};
struct EpiF32 {
    static constexpr bool PERM = false, AFTER_DRAIN = false;
    float* C; int ldc;
    __device__ __forceinline__ void operator()(const f32x4 (&acc)[2][2][4][2], const Unit& u, int wr, int wc, int fr, int fq) const {
        const int row0 = u.pm * BM + wr * 64 + fr, col0 = u.pn * BM + wc * 32 + 4 * fq;
#pragma unroll
        for (int ai = 0; ai < 2; ++ai)
#pragma unroll
            for (int m = 0; m < 4; ++m) { float* rowp = C + (size_t)(row0 + ai * HALF + m * 16) * ldc + col0;
#pragma unroll
                for (int bj = 0; bj < 2; ++bj)
#pragma unroll
                    for (int n = 0; n < 2; ++n) *(f32x4*)(rowp + bj * HALF + n * 16) = acc[ai][bj][m][n]; }
    }
};

template <class Epi, class Sched, bool ALIGN_EPI = false, bool SP2 = false>
__device__ __forceinline__ void gemm_phase(PG8_LAS unsigned char* lds, const Gemm g, const Sched& S, const Epi& E) {
    int tid_ = threadIdx.x; asm volatile("" : "+v"(tid_));
    const int tid = tid_, wid = __builtin_amdgcn_readfirstlane(tid >> 6), lane = tid & 63, wr = wid >> 2, wc = wid & 3, fr = lane & 15, fq = lane >> 4;
    const int K = g.K, nt = K / BK;
    unsigned voffA[2], voffB[2];
#pragma unroll
    for (int i = 0; i < 2; ++i) { int R, C; stage_rc(tid * 16 + i * 8192, R, C); const int Rb = Epi::PERM ? ((R & ~31) + perm32(R & 31)) : R;
        voffA[i] = (unsigned)(R * K + C) * 2u; voffB[i] = (unsigned)(Rb * K + C) * 2u; }
    const size_t kstep = (size_t)(BK * 2);
    const size_t hstep = (size_t)HALF * K * 2;
    const size_t tstep = 2 * hstep;
    const unsigned ldsw = (unsigned)wid * 1024u;
    const int aoff = lds_byte(wr * 64 + fr, fq * 8), boff = lds_byte(wc * 32 + fr, fq * 8);
#define PG8_SA(b, h) (((b) * 2 + (h)) * HTB)
#define PG8_SB(b, h) ((4 + (b) * 2 + (h)) * HTB)
#define PG8_STAGE(bufoff, gbase, voff) do { _Pragma("unroll") for (int _i = 0; _i < 2; ++_i) \
        __builtin_amdgcn_global_load_lds((const unsigned*)((const char*)(gbase) + (voff)[_i]), (PG8_LAS unsigned*)(lds + (bufoff) + ldsw + _i * 8192), 16, 0, 0); } while (0)
#define PG8_LDA(dst, b, h) do { _Pragma("unroll") for (int m = 0; m < 4; ++m) _Pragma("unroll") for (int k = 0; k < 2; ++k) dst[m][k] = *(const PG8_LAS bf16x8*)(lds + PG8_SA(b, h) + aoff + m * 2048 + k * 1024); } while (0)
#define PG8_LDB(dst, b, h) do { _Pragma("unroll") for (int n = 0; n < 2; ++n) _Pragma("unroll") for (int k = 0; k < 2; ++k) dst[n][k] = *(const PG8_LAS bf16x8*)(lds + PG8_SB(b, h) + boff + n * 2048 + k * 1024); } while (0)
#define PG8_MMA(ai, bj, At, Bt) do { __builtin_amdgcn_s_setprio(1); _Pragma("unroll") for (int m = 0; m < 4; ++m) _Pragma("unroll") for (int n = 0; n < 2; ++n) _Pragma("unroll") for (int k = 0; k < 2; ++k) \
        acc[ai][bj][m][n] = __builtin_amdgcn_mfma_f32_16x16x32_bf16(Bt[n][k], At[m][k], acc[ai][bj][m][n], 0, 0, 0); __builtin_amdgcn_s_setprio(0); } while (0)
#define PG8_WAIT_V(n) asm volatile("s_waitcnt vmcnt(" #n ")" ::: "memory")
#define PG8_WAIT_L(n) asm volatile("s_waitcnt lgkmcnt(" #n ")" ::: "memory")
#define PG8_BAR __builtin_amdgcn_s_barrier()
#define PG8_SCHED __builtin_amdgcn_sched_barrier(0)
    Unit cur, nxt; int ui = 0;
    if (!S.next(0, cur)) return;
    f32x4 acc[2][2][4][2];
#pragma unroll
    for (int a = 0; a < 2; ++a)
#pragma unroll
        for (int b = 0; b < 2; ++b)
#pragma unroll
            for (int m = 0; m < 4; ++m)
#pragma unroll
                for (int n = 0; n < 2; ++n) acc[a][b][m][n] = (f32x4){0.f, 0.f, 0.f, 0.f};
    bf16x8 At[4][2], B0[2][2], B1[2][2];
    const char* cA = (const char*)g.A + (size_t)cur.pm * tstep; const char* cB = (const char*)g.Bt + (size_t)cur.pn * tstep;
    S.a_ready(cur);
    if constexpr (SP2) {
        PG8_STAGE(PG8_SB(0, 0), cB, voffB); PG8_STAGE(PG8_SB(0, 1), cB + hstep, voffB); PG8_STAGE(PG8_SA(0, 0), cA, voffA); PG8_STAGE(PG8_SA(0, 1), cA + hstep, voffA);
        if (wr == 1) PG8_BAR;
        PG8_WAIT_V(2); PG8_BAR;
        PG8_STAGE(PG8_SB(1, 0), cB + kstep, voffB); PG8_STAGE(PG8_SA(1, 0), cA + kstep, voffA); PG8_STAGE(PG8_SB(1, 1), cB + hstep + kstep, voffB);
        PG8_WAIT_V(6); PG8_BAR;
    } else {
        PG8_STAGE(PG8_SB(0, 0), cB, voffB); PG8_STAGE(PG8_SA(0, 0), cA, voffA); PG8_STAGE(PG8_SB(0, 1), cB + hstep, voffB); PG8_STAGE(PG8_SA(0, 1), cA + hstep, voffA);
        if (wr == 1) PG8_BAR;
        PG8_WAIT_V(4); PG8_BAR;
        PG8_STAGE(PG8_SB(1, 0), cB + kstep, voffB); PG8_STAGE(PG8_SA(1, 0), cA + kstep, voffA); PG8_STAGE(PG8_SB(1, 1), cB + hstep + kstep, voffB);
        PG8_WAIT_V(6); PG8_BAR;
    }
    for (;;) {
        const bool has_next = S.next(ui + 1, nxt);
        const char* nA = has_next ? (const char*)g.A + (size_t)nxt.pm * tstep : cA; const char* nB = has_next ? (const char*)g.Bt + (size_t)nxt.pn * tstep : cB;
        for (int t = 0; t < nt; t += 2) {
            const bool last = (t == nt - 2);
            const char* a1 = cA + (size_t)(t + 1) * kstep;
            const char* a2 = last ? nA : cA + (size_t)(t + 2) * kstep; const char* b2 = last ? nB : cB + (size_t)(t + 2) * kstep;
            const char* a3 = a2 + kstep; const char* b3 = b2 + kstep;
            if (last && has_next) S.a_ready(nxt);
            if constexpr (SP2) {
            PG8_LDB(B0, 0, 0); PG8_LDB(B1, 0, 1); PG8_SCHED; PG8_LDA(At, 0, 0); PG8_STAGE(PG8_SA(1, 1), a1 + hstep, voffA);
            PG8_WAIT_V(8); PG8_WAIT_L(0); PG8_BAR; PG8_MMA(0, 0, At, B0); PG8_MMA(0, 1, At, B1); PG8_BAR; PG8_SCHED;
            PG8_LDA(At, 0, 1); PG8_STAGE(PG8_SB(0, 0), b2, voffB); PG8_STAGE(PG8_SB(0, 1), b2 + hstep, voffB); PG8_STAGE(PG8_SA(0, 0), a2, voffA);
            PG8_WAIT_V(8); PG8_WAIT_L(0); PG8_BAR; PG8_MMA(1, 0, At, B0); PG8_MMA(1, 1, At, B1); PG8_BAR; PG8_SCHED;
            PG8_LDB(B0, 1, 0); PG8_LDB(B1, 1, 1); PG8_SCHED; PG8_LDA(At, 1, 0); PG8_STAGE(PG8_SA(0, 1), a2 + hstep, voffA);
            PG8_WAIT_V(8); PG8_WAIT_L(0); PG8_BAR; PG8_MMA(0, 0, At, B0); PG8_MMA(0, 1, At, B1); PG8_BAR; PG8_SCHED;
            PG8_LDA(At, 1, 1); PG8_STAGE(PG8_SB(1, 0), b3, voffB); PG8_STAGE(PG8_SB(1, 1), b3 + hstep, voffB); PG8_STAGE(PG8_SA(1, 0), a3, voffA);
            PG8_WAIT_V(8); PG8_WAIT_L(0); PG8_BAR; PG8_MMA(1, 0, At, B0); PG8_MMA(1, 1, At, B1); PG8_BAR; PG8_SCHED;
            } else {
            PG8_LDB(B0, 0, 0); PG8_SCHED; PG8_LDA(At, 0, 0); PG8_STAGE(PG8_SA(1, 1), a1 + hstep, voffA);
            PG8_WAIT_L(8); PG8_BAR; PG8_WAIT_L(0); PG8_MMA(0, 0, At, B0); PG8_BAR; PG8_SCHED;
            PG8_LDB(B1, 0, 1); PG8_STAGE(PG8_SB(0, 0), b2, voffB);
            PG8_BAR; PG8_WAIT_L(0); PG8_MMA(0, 1, At, B1); PG8_BAR;
            PG8_LDA(At, 0, 1); PG8_STAGE(PG8_SA(0, 0), a2, voffA);
            PG8_BAR; PG8_WAIT_L(0); PG8_MMA(1, 0, At, B0); PG8_BAR; PG8_SCHED;
            PG8_STAGE(PG8_SB(0, 1), b2 + hstep, voffB);
            PG8_WAIT_V(6); PG8_BAR; PG8_MMA(1, 1, At, B1); PG8_BAR;
            PG8_LDB(B0, 1, 0); PG8_SCHED; PG8_LDA(At, 1, 0); PG8_STAGE(PG8_SA(0, 1), a2 + hstep, voffA);
            PG8_WAIT_L(8); PG8_BAR; PG8_WAIT_L(0); PG8_MMA(0, 0, At, B0); PG8_BAR; PG8_SCHED;
            PG8_LDB(B1, 1, 1); PG8_STAGE(PG8_SB(1, 0), b3, voffB);
            PG8_BAR; PG8_WAIT_L(0); PG8_MMA(0, 1, At, B1); PG8_BAR;
            PG8_LDA(At, 1, 1); PG8_STAGE(PG8_SA(1, 0), a3, voffA);
            PG8_BAR; PG8_WAIT_L(0); PG8_MMA(1, 0, At, B0); PG8_BAR; PG8_SCHED;
            PG8_STAGE(PG8_SB(1, 1), b3 + hstep, voffB);
            PG8_WAIT_V(6); PG8_BAR; PG8_MMA(1, 1, At, B1); PG8_BAR;
            }
        }
        if constexpr (ALIGN_EPI) { if (wr == 0) PG8_BAR; }
        if constexpr (!Epi::AFTER_DRAIN) { E(acc, cur, wr, wc, fr, fq); S.done(cur); }
        if (!has_next) break;
#pragma unroll
        for (int a = 0; a < 2; ++a)
#pragma unroll
            for (int b = 0; b < 2; ++b)
#pragma unroll
                for (int m = 0; m < 4; ++m)
#pragma unroll
                    for (int n = 0; n < 2; ++n) acc[a][b][m][n] = (f32x4){0.f, 0.f, 0.f, 0.f};
        cur = nxt; cA = nA; cB = nB; ++ui;
        if constexpr (ALIGN_EPI) { if (wr == 1) PG8_BAR; }
    }
    PG8_WAIT_V(0);
    if constexpr (!ALIGN_EPI) { if (wr == 0) PG8_BAR; }
    PG8_BAR;
    if constexpr (Epi::AFTER_DRAIN) { E.fused(acc, cur, wr, wc, fr, fq, lds, wid, lane); S.done(cur); }
#undef PG8_SA
#undef PG8_SB
#undef PG8_STAGE
#undef PG8_LDA
#undef PG8_LDB
#undef PG8_MMA
#undef PG8_WAIT_V
#undef PG8_WAIT_L
#undef PG8_BAR
#undef PG8_SCHED
}
}
#define GAS __attribute__((address_space(1)))
#define LAS __attribute__((address_space(3)))
typedef unsigned short bf16;
typedef unsigned v4u __attribute__((ext_vector_type(4)));
typedef float f32x4 __attribute__((ext_vector_type(4)));
typedef short bf16x8 __attribute__((ext_vector_type(8)));
typedef GAS unsigned gu32;
typedef GAS unsigned long long gu64;
#define RLX_AGENT __ATOMIC_RELAXED, __HIP_MEMORY_SCOPE_AGENT
#define LDS_WAIT() asm volatile("s_waitcnt lgkmcnt(0)" ::: "memory")
#define VM_WAIT() asm volatile("s_waitcnt vmcnt(0)" ::: "memory")
__device__ __forceinline__ unsigned long long rt() { return __builtin_amdgcn_s_memrealtime(); }
__device__ __forceinline__ unsigned f2bf(float f) { unsigned u = __builtin_bit_cast(unsigned, f); return (u + 0x7fffu + ((u >> 16) & 1u)) >> 16; }
__device__ __forceinline__ unsigned pk2(float lo, float hi) { return f2bf(lo) | (f2bf(hi) << 16); }

#define XB_TMO      128
#define XB_XCNT(j)  (256  + 64 * (j))
#define XB_XSUB(j)  (1280 + 64 * (j))
#define XB_XGEN(j)  (2304 + 64 * (j))
#define XB_TOP      3328
#define XB_TOPGEN   3392
#define XCD_BAR_WORDS 3456
#define XB_SPIN_CAP (1u << 18)

__device__ __forceinline__ unsigned xb_ld(unsigned* p)              { return __hip_atomic_load(p, __ATOMIC_RELAXED, __HIP_MEMORY_SCOPE_AGENT); }
__device__ __forceinline__ unsigned xb_add(unsigned* p, unsigned v) { return __hip_atomic_fetch_add(p, v, __ATOMIC_RELAXED, __HIP_MEMORY_SCOPE_AGENT); }
__device__ __forceinline__ unsigned xb_xcc_id() { return (unsigned)__builtin_amdgcn_s_getreg((3 << 11) | 20) & 0xFu; }
#define XB_SPIN(cond, bar) do { unsigned _sp = 0; while (cond) { __builtin_amdgcn_s_sleep(1); \
    if ((++_sp & 255u) == 0u) { if (xb_ld(&(bar)[XB_TMO])) break; if (_sp > XB_SPIN_CAP) { atomicAdd(&(bar)[XB_TMO], 1u); break; } } } } while (0)

struct XcdBarrier {
    unsigned* bar; unsigned x;
    volatile LAS unsigned* st;
};

__device__ __forceinline__ XcdBarrier xcd_barrier_post(unsigned* bar, volatile LAS unsigned* st) {
    XcdBarrier b; b.bar = bar; b.x = xb_xcc_id(); b.st = st;
    if (threadIdx.x == 0) (void)xb_add(&bar[XB_XCNT(b.x)], 1u);
    return b;
}
__device__ __forceinline__ void xcd_barrier_complete(unsigned* bar, unsigned x, unsigned& nloc, unsigned& nx) {
    const unsigned G = gridDim.x * gridDim.y * gridDim.z;
    unsigned sum, cnt, mine, sp = 0u;
    for (;;) {
        sum = 0u; cnt = 0u; mine = 0u;
#pragma unroll
        for (unsigned j = 0; j < 16; ++j) { const unsigned c = xb_ld(&bar[XB_XCNT(j)]); sum += c; cnt += (c > 0u) ? 1u : 0u; mine = (j == x) ? c : mine; }
        if (sum == G) break;
        __builtin_amdgcn_s_sleep(1);
        if ((++sp & 255u) == 0u) { if (xb_ld(&bar[XB_TMO])) break; if (sp > XB_SPIN_CAP) { atomicAdd(&bar[XB_TMO], 1u); break; } }
    }
    nloc = mine > 0u ? mine : 1u; nx = cnt > 0u ? cnt : 1u;
}

__device__ __forceinline__ void xcd_barrier(const XcdBarrier& b) {
    asm volatile("s_waitcnt vmcnt(0)" ::: "memory");
    __syncthreads();
    if (threadIdx.x == 0) {
        unsigned* bar = b.bar;
        __builtin_amdgcn_s_waitcnt(0);
        unsigned nloc = b.st[0], nx = b.st[1];
        if (nloc == 0u) { xcd_barrier_complete(bar, b.x, nloc, nx); b.st[0] = nloc; b.st[1] = nx; }
        const unsigned old = xb_add(&bar[XB_XSUB(b.x)], 1u);
        const unsigned gen = old / nloc;
        if (old + 1u == (gen + 1u) * nloc) {
            __builtin_amdgcn_fence(__ATOMIC_RELEASE, "agent");
            asm volatile("s_waitcnt vmcnt(0)" ::: "memory");
            const unsigned og = xb_add(&bar[XB_TOP], 1u);
            const unsigned tg = og / nx;
            if (og + 1u == (tg + 1u) * nx) xb_add(&bar[XB_TOPGEN], 1u);
            else XB_SPIN(xb_ld(&bar[XB_TOPGEN]) == tg, bar);
            __builtin_amdgcn_fence(__ATOMIC_ACQUIRE, "agent");
            xb_add(&bar[XB_XGEN(b.x)], 1u);
            asm volatile("s_waitcnt vmcnt(0)" ::: "memory");
        } else {
            XB_SPIN(xb_ld(&bar[XB_XGEN(b.x)]) == gen, bar);
            __builtin_amdgcn_fence(__ATOMIC_ACQUIRE, "agent");
            asm volatile("s_waitcnt vmcnt(0)" ::: "memory");
        }
    }
    __syncthreads();
}

constexpr size_t MiB = 1u << 20;
constexpr size_t WS_CTL = 0, CTL_ZERO_BYTES = 1 * MiB;
constexpr size_t WS_WIN = 2 * MiB;
constexpr size_t WS_WOUT = 26 * MiB;
constexpr size_t WS_XN = 34 * MiB;
constexpr size_t WS_P = 68 * MiB;
constexpr size_t WS_Y = 170 * MiB;
constexpr size_t WS_YF = WS_P;
constexpr size_t WS_WTRIL = 204 * MiB;
constexpr size_t WS_END = 205 * MiB;
constexpr int CW_BAR = 4096;

constexpr int RING_OFF = 0, RING_BYTES = 131072;
constexpr int KV_OFF = 0;
constexpr int TABB_OFF = 65536, TABC_OFF = TABB_OFF + 8 * 2 * 264 * 4, WSF_OFF = TABC_OFF + 4 * 2 * 264 * 4;
constexpr int STG_OFF = 96 * 1024;
static_assert(WSF_OFF + 8 * 64 * 4 <= STG_OFF && STG_OFF + 8 * 4096 <= RING_BYTES, "MIX LDS map");
constexpr int LDSCTL_OFF = RING_BYTES, MISC_OFF = LDSCTL_OFF + 320;
constexpr int LDS_BYTES = 147456;
static_assert(MISC_OFF + 128 <= LDS_BYTES, "LDS map");
constexpr int NWAVES = 8;

struct Args { const float* in[16]; float* out; unsigned char* ws; int ph_lo, ph_hi; };
struct Frame {
    LAS unsigned char* lds;
    unsigned char* ws;
    int tid, lane, wave;
    int vcu, G;
    float* out;
    __device__ __forceinline__ bf16* Win_t() const { return (bf16*)(ws + WS_WIN); }
    __device__ __forceinline__ bf16* Wout_t() const { return (bf16*)(ws + WS_WOUT); }
    __device__ __forceinline__ bf16* XN() const { return (bf16*)(ws + WS_XN); }
    __device__ __forceinline__ bf16* P() const { return (bf16*)(ws + WS_P); }
    __device__ __forceinline__ bf16* Y() const { return (bf16*)(ws + WS_Y); }
    __device__ __forceinline__ bf16* Wtril() const { return (bf16*)(ws + WS_WTRIL); }
    __device__ __forceinline__ float* YF() const { return (float*)(ws + WS_YF); }
};

__device__ __forceinline__ float bf2f(bf16 v) { return __builtin_bit_cast(float, (unsigned)v << 16); }
__device__ __forceinline__ float wave_sum(float v) {
#pragma unroll
    for (int o = 1; o < 64; o <<= 1) v += __shfl_xor(v, o);
    return v;
}
__device__ __forceinline__ void p0_transpose_item(const float* W, int K, int N, bf16* WT, LAS float* scr, int item, int lane) {
    const int nblk = N / 32, kb = item / nblk, nb = item % nblk, k0 = 64 * kb, n0 = 32 * nb;
#pragma unroll 8
    for (int i = 0; i < 32; ++i) { const int kk = 2 * i + (lane >> 5); scr[kk * 33 + (lane & 31)] = W[(size_t)(k0 + kk) * N + n0 + (lane & 31)]; }
    LDS_WAIT(); asm volatile("" ::: "memory");
    const int c = lane & 7;
#pragma unroll
    for (int j = 0; j < 4; ++j) { const int n = (lane >> 3) + 8 * j; const LAS float* s = scr + (8 * c) * 33 + n;
        v4u o; o.x = pk2(s[0 * 33], s[1 * 33]); o.y = pk2(s[2 * 33], s[3 * 33]); o.z = pk2(s[4 * 33], s[5 * 33]); o.w = pk2(s[6 * 33], s[7 * 33]);
        *(GAS v4u*)(WT + (size_t)(n0 + n) * K + k0 + 8 * c) = o; }
    LDS_WAIT(); asm volatile("" ::: "memory");
}
__device__ __forceinline__ void rms_row_to_bf16(int lane, const float* xrow, const float* g, bf16* orow) {
    const GAS f32x4* xr = (const GAS f32x4*)xrow + lane; const GAS f32x4* gr = (const GAS f32x4*)g + lane;
    f32x4 v[4]; float s = 0.f;
#pragma unroll
    for (int j = 0; j < 4; ++j) { v[j] = xr[64 * j]; s += (v[j].x * v[j].x + v[j].y * v[j].y) + (v[j].z * v[j].z + v[j].w * v[j].w); }
    const float rstd = 1.f / sqrtf(wave_sum(s) * (1.f / D) + RMS_EPS);
    GAS unsigned long long* o8 = (GAS unsigned long long*)orow + lane;
#pragma unroll
    for (int j = 0; j < 4; ++j) { const f32x4 gg = gr[64 * j];
        o8[64 * j] = (unsigned long long)pk2(v[j].x * rstd * gg.x, v[j].y * rstd * gg.y) | ((unsigned long long)pk2(v[j].z * rstd * gg.z, v[j].w * rstd * gg.w) << 32); }
}
__device__ __forceinline__ const float* x_in_row(const Args& A, int m) { return m < NPROMPT ? A.in[0] + (size_t)m * D : A.in[1] + (size_t)(m - NPROMPT) * D; }

__device__ __forceinline__ void p0_prologue(Frame& F0, const Args& A) {
    Frame F = F0;
    { int tid = threadIdx.x; asm volatile("" : "+v"(tid)); F.tid = tid; F.lane = tid & 63; F.wave = __builtin_amdgcn_readfirstlane(tid >> 6); }
    LAS float* scr = (LAS float*)(F.lds + RING_OFF + F.wave * 16384);
    const int gw = F.vcu * NWAVES + F.wave, NGW = F.G * NWAVES;
    constexpr int I_IN = (D / 64) * (NIN / 32), I_OUT = (D / 64) * (D / 32);
    constexpr int NITEMS = DEPTH * (I_IN + I_OUT);
    for (int it = gw; it < NITEMS; it += NGW) {
        const int l = it / (I_IN + I_OUT); int r = it % (I_IN + I_OUT);
        if (r < I_IN) p0_transpose_item(A.in[8] + (size_t)l * D * NIN, D, NIN, F.Win_t() + (size_t)l * NIN * D, scr, r, F.lane);
        else p0_transpose_item(A.in[9] + (size_t)l * D * D, D, D, F.Wout_t() + (size_t)l * D * D, scr, r - I_IN, F.lane);
    }
    for (int m = gw; m < M; m += NGW) rms_row_to_bf16(F.lane, x_in_row(A, m), A.in[6], F.XN() + (size_t)m * D);
    for (int i = (F.vcu * NWAVES * 64 + F.tid) * 8; i < DEPTH * 4 * 128 * 128; i += F.G * NWAVES * 64 * 8) {
        const int s0 = i & 127, t = (i >> 7) & 127; const float* wp = A.in[11] + i;
        const f32x4 x = *(const GAS f32x4*)wp, y = *(const GAS f32x4*)(wp + 4);
        v4u o; o.x = pk2(s0 + 0 <= t ? x.x : 0.f, s0 + 1 <= t ? x.y : 0.f); o.y = pk2(s0 + 2 <= t ? x.z : 0.f, s0 + 3 <= t ? x.w : 0.f);
        o.z = pk2(s0 + 4 <= t ? y.x : 0.f, s0 + 5 <= t ? y.y : 0.f); o.w = pk2(s0 + 6 <= t ? y.z : 0.f, s0 + 7 <= t ? y.w : 0.f);
        *(GAS v4u*)(F.Wtril() + i) = o; }
}

__device__ __forceinline__ void post_phase(Frame& F0, const Args& A, int layer) {
    Frame F = F0;
    { int tid = threadIdx.x; asm volatile("" : "+v"(tid)); F.tid = tid; F.lane = tid & 63; F.wave = __builtin_amdgcn_readfirstlane(tid >> 6); }
    const int gw = F.vcu * NWAVES + F.wave, NGW = F.G * NWAVES; const int lane = F.lane;
    const GAS f32x4* gp = (const GAS f32x4*)(A.in[7] + (size_t)layer * D) + lane;
    const GAS f32x4* gn = (const GAS f32x4*)(A.in[6] + (size_t)(layer + 1 < DEPTH ? layer + 1 : 0) * D) + lane;
    for (int m = gw; m < M; m += NGW) {
        const GAS f32x4* yr = (const GAS f32x4*)(F.YF() + (size_t)m * D) + lane;
        const GAS f32x4* xr = (const GAS f32x4*)(layer == 0 ? x_in_row(A, m) : F.out + (size_t)m * D) + lane;
        GAS f32x4* xo = (GAS f32x4*)(F.out + (size_t)m * D) + lane;
        f32x4 y[4], x[4]; float s = 0.f;
#pragma unroll
        for (int j = 0; j < 4; ++j) { y[j] = yr[64 * j]; x[j] = xr[64 * j]; s += (y[j].x * y[j].x + y[j].y * y[j].y) + (y[j].z * y[j].z + y[j].w * y[j].w); }
        const float rstd = 1.f / sqrtf(wave_sum(s) * (1.f / D) + RMS_EPS); float s2 = 0.f;
#pragma unroll
        for (int j = 0; j < 4; ++j) { const f32x4 g = gp[64 * j]; x[j] = x[j] + y[j] * rstd * g; xo[64 * j] = x[j]; s2 += (x[j].x * x[j].x + x[j].y * x[j].y) + (x[j].z * x[j].z + x[j].w * x[j].w); }
        if (layer + 1 < DEPTH) {
            const float r2 = 1.f / sqrtf(wave_sum(s2) * (1.f / D) + RMS_EPS);
            GAS unsigned long long* o8 = (GAS unsigned long long*)(F.XN() + (size_t)m * D) + lane;
#pragma unroll
            for (int j = 0; j < 4; ++j) { const f32x4 g = gn[64 * j];
                o8[64 * j] = (unsigned long long)pk2(x[j].x * r2 * g.x, x[j].y * r2 * g.y) | ((unsigned long long)pk2(x[j].z * r2 * g.z, x[j].w * r2 * g.w) << 32); }
        }
    }
}

__device__ __forceinline__ float silu_f(float z) { return z / (1.f + __expf(-z)); }
__device__ __forceinline__ int t5_bucket(int rel) {
    const int n = rel < 0 ? -rel : rel;
    const int lg = 8 + (n >= 12) + (n >= 16) + (n >= 23) + (n >= 32) + (n >= 46) + (n >= 64) + (n >= 91);
    return (rel > 0 ? 16 : 0) + (n < 8 ? n : lg);
}
__device__ __forceinline__ void attn_simple(Frame& F, const Args& A, LAS float* scr, const LAS float* T5, const LAS float* CR, int lane, int KIND,
        int qrow, int qcol, int h, int qpos, bool writer,
        int nct, const float* cK, const float* cV, int cstride,
        int npt, int prow0, int kcol, int vcol,
        int kpos0,
        float sink, bool has_sink, int zcol, int ycol) {
    LAS float* Kl = scr; LAS float* Vl = scr + 2048;
    float q[64], o[64];
    { const bf16* qp = F.P() + (size_t)qrow * NIN + qcol;
#pragma unroll
      for (int d8 = 0; d8 < 8; ++d8) { const v4u w = *(const GAS v4u*)(qp + 8 * d8);
          q[8 * d8 + 0] = __builtin_bit_cast(float, w.x << 16) * 0.125f; q[8 * d8 + 1] = __builtin_bit_cast(float, w.x & 0xffff0000u) * 0.125f;
          q[8 * d8 + 2] = __builtin_bit_cast(float, w.y << 16) * 0.125f; q[8 * d8 + 3] = __builtin_bit_cast(float, w.y & 0xffff0000u) * 0.125f;
          q[8 * d8 + 4] = __builtin_bit_cast(float, w.z << 16) * 0.125f; q[8 * d8 + 5] = __builtin_bit_cast(float, w.z & 0xffff0000u) * 0.125f;
          q[8 * d8 + 6] = __builtin_bit_cast(float, w.w << 16) * 0.125f; q[8 * d8 + 7] = __builtin_bit_cast(float, w.w & 0xffff0000u) * 0.125f; } }
#pragma unroll
    for (int d = 0; d < 64; ++d) o[d] = 0.f;
    float mrun = has_sink ? sink : -1e30f, lrun = has_sink ? 1.f : 0.f;
    const int nt = nct + npt;
    for (int t = 0; t < nt; ++t) {
        asm volatile("s_waitcnt lgkmcnt(0)" ::: "memory");
        if (t < nct) { const float* kp = cK + (size_t)(t * 32) * cstride + lane; const float* vp = cV + (size_t)(t * 32) * cstride + lane;
#pragma unroll 4
            for (int e = 0; e < 32; ++e) { Kl[e * 64 + lane] = kp[(size_t)e * cstride]; Vl[e * 64 + lane] = vp[(size_t)e * cstride]; }
        } else { const bf16* kp = F.P() + (size_t)(prow0 + (t - nct) * 32) * NIN + lane;
#pragma unroll 4
            for (int e = 0; e < 32; ++e) { Kl[e * 64 + lane] = bf2f(kp[(size_t)e * NIN + kcol]); Vl[e * 64 + lane] = bf2f(kp[(size_t)e * NIN + vcol]); }
        }
        asm volatile("s_waitcnt vmcnt(0) lgkmcnt(0)" ::: "memory");
        const int relb = kpos0 + t * 32 - qpos;
#pragma unroll 1
        for (int jj = 0; jj < 32; ++jj) {
            const LAS f32x4* k4 = (const LAS f32x4*)(Kl + jj * 64);
            float s0 = 0.f, s1 = 0.f;
#pragma unroll
            for (int d4 = 0; d4 < 16; d4 += 2) { const f32x4 a = k4[d4], b = k4[d4 + 1];
                s0 += q[4 * d4] * a.x + q[4 * d4 + 1] * a.y + q[4 * d4 + 2] * a.z + q[4 * d4 + 3] * a.w;
                s1 += q[4 * d4 + 4] * b.x + q[4 * d4 + 5] * b.y + q[4 * d4 + 6] * b.z + q[4 * d4 + 7] * b.w;
                if ((d4 & 3) == 2) asm volatile("" ::: "memory"); }
            const int rel = relb + jj;
            float bias;
            if (KIND == 0) bias = T5[t5_bucket(rel) * 8 + h];
            else { const int ci = (rel < -128 ? -128 : (rel > 128 ? 128 : rel)) + 128; bias = CR[ci * 4 + h]; }
            const float s = s0 + s1 + bias;
            if (s > mrun) { const float sc = __expf(mrun - s); lrun *= sc;
#pragma unroll
                for (int d = 0; d < 64; ++d) o[d] *= sc;
                mrun = s; }
            const float p = __expf(s - mrun); lrun += p;
            const LAS f32x4* v4 = (const LAS f32x4*)(Vl + jj * 64);
#pragma unroll
            for (int d4 = 0; d4 < 16; ++d4) { const f32x4 a = v4[d4]; o[4 * d4] += p * a.x; o[4 * d4 + 1] += p * a.y; o[4 * d4 + 2] += p * a.z; o[4 * d4 + 3] += p * a.w;
                if ((d4 & 3) == 3) asm volatile("" ::: "memory"); }
        }
    }
    const float inv = 1.f / lrun;
    if (writer) { const bf16* zp = F.P() + (size_t)qrow * NIN + zcol; bf16* yp = F.Y() + (size_t)qrow * D + ycol;
#pragma unroll
        for (int d8 = 0; d8 < 8; ++d8) { const v4u w = *(const GAS v4u*)(zp + 8 * d8); float z[8];
            z[0] = __builtin_bit_cast(float, w.x << 16); z[1] = __builtin_bit_cast(float, w.x & 0xffff0000u); z[2] = __builtin_bit_cast(float, w.y << 16); z[3] = __builtin_bit_cast(float, w.y & 0xffff0000u);
            z[4] = __builtin_bit_cast(float, w.z << 16); z[5] = __builtin_bit_cast(float, w.z & 0xffff0000u); z[6] = __builtin_bit_cast(float, w.w << 16); z[7] = __builtin_bit_cast(float, w.w & 0xffff0000u);
            v4u r; r.x = pk2(o[8 * d8] * inv * silu_f(z[0]), o[8 * d8 + 1] * inv * silu_f(z[1])); r.y = pk2(o[8 * d8 + 2] * inv * silu_f(z[2]), o[8 * d8 + 3] * inv * silu_f(z[3]));
            r.z = pk2(o[8 * d8 + 4] * inv * silu_f(z[4]), o[8 * d8 + 5] * inv * silu_f(z[5])); r.w = pk2(o[8 * d8 + 6] * inv * silu_f(z[6]), o[8 * d8 + 7] * inv * silu_f(z[7]));
            *(GAS v4u*)(yp + 8 * d8) = r; } }
}

__device__ __forceinline__ void mixa_simple(Frame& F, const Args& A, LAS float* scr, int lane, int layer, int T, int row0, int g, float* avs_out  ) {
    constexpr int TM = 128;
    LAS float* rs = scr;
    LAS float* wr = scr + 128;
    const int c = g * 64 + lane;
    for (int s = 0; s < T; ++s) {
        const unsigned long long w = *(const GAS unsigned long long*)(F.P() + (size_t)(row0 + s) * NIN + PC_AV + 4 * lane);
        const float a = __builtin_bit_cast(float, (unsigned)w << 16), b = __builtin_bit_cast(float, (unsigned)w & 0xffff0000u), cc = __builtin_bit_cast(float, (unsigned)(w >> 32) << 16), dd = __builtin_bit_cast(float, (unsigned)(w >> 32) & 0xffff0000u);
        const float ss = wave_sum((a * a + b * b) + (cc * cc + dd * dd));
        if (lane == 0) rs[s] = 1.f / sqrtf(ss * (1.f / 256.f) + RMS_EPS);
    }
    asm volatile("s_waitcnt lgkmcnt(0)" ::: "memory");
    const float ga = A.in[10][(size_t)layer * 256 + c];
    float vn[TM];
    { const bf16* vp = F.P() + (size_t)row0 * NIN + PC_AV + c;
#pragma unroll
      for (int s8 = 0; s8 < TM; s8 += 8) {
          if (s8 < T) {
#pragma unroll
              for (int s = s8; s < s8 + 8; ++s) vn[s] = bf2f(vp[(size_t)(s - s8) * NIN]) * rs[s] * ga;
              if (avs_out) {
#pragma unroll
                  for (int s = s8; s < s8 + 8; ++s) avs_out[(size_t)s * 256 + c] = vn[s];
              }
          } else {
#pragma unroll
              for (int s = s8; s < s8 + 8; ++s) vn[s] = 0.f;
          }
          vp += 8 * NIN; asm volatile("" : "+v"(vp) :: "memory"); } }
    const float* Wg = A.in[11] + ((size_t)layer * 4 + g) * 128 * 128; const float* bsg = A.in[12] + ((size_t)layer * 4 + g) * 128;
    for (int t = 0; t < T; ++t) {
        asm volatile("s_waitcnt lgkmcnt(0)" ::: "memory");
        for (int s = lane; s < TM; s += 64) wr[s] = (s <= t) ? Wg[(size_t)t * 128 + s] : 0.f;
        asm volatile("s_waitcnt vmcnt(0) lgkmcnt(0)" ::: "memory");
        float a0 = bsg[t], a1 = 0.f;
        const LAS f32x4* w4 = (const LAS f32x4*)wr;
#pragma unroll
        for (int s4 = 0; s4 < TM / 4; s4 += 2) { const f32x4 a = w4[s4], b = w4[s4 + 1];
            a0 += a.x * vn[4 * s4] + a.y * vn[4 * s4 + 1] + a.z * vn[4 * s4 + 2] + a.w * vn[4 * s4 + 3];
            a1 += b.x * vn[4 * s4 + 4] + b.y * vn[4 * s4 + 5] + b.z * vn[4 * s4 + 6] + b.w * vn[4 * s4 + 7];
            if ((s4 & 7) == 6) asm volatile("" ::: "memory"); }
        const bf16* pr = F.P() + (size_t)(row0 + t) * NIN;
        const float y = bf2f(pr[PC_AU + c]) * (a0 + a1) * silu_f(bf2f(pr[PC_AZ + c]));
        F.Y()[(size_t)(row0 + t) * D + YC_A + c] = (bf16)f2bf(y);
    }
}

constexpr int U_AP = 8 * 16 * 4, U_AS = 32 * 4, U_BP = 8 * 32 * 8, U_BS = 32 * 2 * 2, U_CP = 8 * 32 * 4, U_CS = 32 * 4;
constexpr int U_ATT = U_CP + U_BP + U_CS + U_BS, U_TOTAL = U_ATT + U_AP + U_AS;
template <int NW>
__device__ __forceinline__ void mix_phase_simple(Frame& F, const Args& A, int layer) {
    { LAS float* T5 = (LAS float*)(F.lds + NW * 16384); LAS float* CR = (LAS float*)(F.lds + NW * 16384 + 1024);
      for (int i = F.tid; i < 256; i += NW * 64) T5[i] = A.in[15][i];
      for (int i = F.tid; i < 257 * 4; i += NW * 64) CR[i] = A.in[14][(size_t)layer * 257 * 4 + i];
      __syncthreads(); }
    LAS float* scr = (LAS float*)(F.lds + RING_OFF + F.wave * 16384);
    const int gw = F.vcu * NW + F.wave, NGW = F.G * NW; const int lane = F.lane;
    for (int u0 = gw; u0 < U_TOTAL; u0 += NGW) {
        int u = u0;
        if (u < U_ATT) {
            int kind, qrow, qcol, h, qpos, nct = 0, cstride = 0, npt, prow0, kcol, vcol, kpos0, zcol, ycol; bool writer = true, has_sink; float sink = 0.f; const float* cK = nullptr; const float* cV = nullptr;
            if (u < U_CP) { h = u & 3; const int n = (u >> 2) & 31, b = u >> 7; const int c0 = n >= 8 ? n - 8 : 0; qrow = b * SEQ + n * 64 + lane;
                kind = 1; qcol = PC_CQ + h * 64; qpos = qrow; npt = 2 * (n + 1 - c0); prow0 = b * SEQ + c0 * 64; kcol = PC_CK + h * 64; vcol = PC_CV + h * 64; kpos0 = prow0; has_sink = false; zcol = PC_CZ + h * 64; ycol = YC_C + h * 64; }
            else if (u < U_CP + U_BP) { u -= U_CP; h = u & 7; const int n = (u >> 3) & 31, b = u >> 8; const int c0 = n >= 2 ? n - 2 : 0; qrow = b * SEQ + n * 64 + lane; const int kvh = h >> 2;
                kind = 0; qcol = PC_BQ + h * 64; qpos = qrow; npt = 2 * (n + 1 - c0); prow0 = b * SEQ + c0 * 64; kcol = PC_BK + kvh * 64; vcol = PC_BV + kvh * 64; kpos0 = prow0; has_sink = true; zcol = PC_BZ + h * 64; ycol = YC_B + h * 64; }
            else if (u < U_CP + U_BP + U_CS) { u -= U_CP + U_BP; h = u & 3; const int s = u >> 2; const int i = lane & 31; qrow = NPROMPT + s * 32 + i;
                cK = A.in[4] + ((size_t)(layer * 32 + s) * 512) * 256 + h * 64; cV = A.in[5] + ((size_t)(layer * 32 + s) * 512) * 256 + h * 64;
                kind = 1; qcol = PC_CQ + h * 64; qpos = i; writer = lane < 32; nct = 16; cstride = 256; npt = 1; prow0 = NPROMPT + s * 32; kcol = PC_CK + h * 64; vcol = PC_CV + h * 64; kpos0 = -512; has_sink = false; zcol = PC_CZ + h * 64; ycol = YC_C + h * 64; }
            else { u -= U_CP + U_BP + U_CS; const int gp = u & 1, kvh = (u >> 1) & 1, s = u >> 2; const int i = lane & 31; h = kvh * 4 + gp * 2 + (lane >> 5); qrow = NPROMPT + s * 32 + i;
                cK = A.in[2] + ((size_t)(layer * 32 + s) * 128) * 128 + kvh * 64; cV = A.in[3] + ((size_t)(layer * 32 + s) * 128) * 128 + kvh * 64;
                kind = 0; qcol = PC_BQ + h * 64; qpos = i; nct = 4; cstride = 128; npt = 1; prow0 = NPROMPT + s * 32; kcol = PC_BK + kvh * 64; vcol = PC_BV + kvh * 64; kpos0 = -128; has_sink = true; zcol = PC_BZ + h * 64; ycol = YC_B + h * 64; }
            if (has_sink) sink = A.in[13][layer * 8 + h];
            attn_simple(F, A, scr, (const LAS float*)(F.lds + NW * 16384), (const LAS float*)(F.lds + NW * 16384 + 1024), lane, kind, qrow, qcol, h, qpos, writer, nct, cK, cV, cstride, npt, prow0, kcol, vcol, kpos0, sink, has_sink, zcol, ycol);
        } else {
            u -= U_ATT;
            int T, row0, g; float* avs = nullptr;
            if (u < U_AP) { g = u & 3; const int n = (u >> 2) & 15, b = u >> 6; T = 128; row0 = b * SEQ + n * 128; }
            else { u -= U_AP; g = u & 3; const int s = u >> 2; T = 32; row0 = NPROMPT + s * 32; avs = F.out + O_AVS + ((size_t)layer * NSAMP + s * 32) * 256; }
            mixa_simple(F, A, scr, lane, layer, T, row0, g, avs);
        }
    }
}


namespace mx {
typedef float f32x16 __attribute__((ext_vector_type(16)));
typedef float f32x2 __attribute__((ext_vector_type(2)));
typedef short s16x4 __attribute__((ext_vector_type(4)));
typedef unsigned u32x2 __attribute__((ext_vector_type(2)));
typedef __bf16 bf16x2_t __attribute__((ext_vector_type(2)));
constexpr float LOG2E = 1.4426950408889634f;
constexpr int TABW = 264;
__device__ __forceinline__ int crow(int r, int hi) { return (r & 3) + 8 * (r >> 2) + 4 * hi; }
__device__ __forceinline__ unsigned cvtpk(float lo, float hi) { f32x2 v = {lo, hi}; bf16x2_t b = __builtin_convertvector(v, bf16x2_t); return __builtin_bit_cast(unsigned, b); }
__device__ __forceinline__ s16x4 vtr(const LAS unsigned char* p) { typedef short v4i16_t __attribute__((ext_vector_type(4))); return __builtin_bit_cast(s16x4, __builtin_amdgcn_ds_read_tr16_b64_v4i16((LAS v4i16_t*)p)); }
__device__ __forceinline__ float silu(float z) { return z * __builtin_amdgcn_rcpf(1.f + __builtin_amdgcn_exp2f(-z * LOG2E)); }
__device__ __forceinline__ float u2f(unsigned u) { return __builtin_bit_cast(float, u); }
__device__ __forceinline__ float bfl(unsigned w) { return __builtin_bit_cast(float, w << 16); }
__device__ __forceinline__ float bfh(unsigned w) { return __builtin_bit_cast(float, w & 0xffff0000u); }

__device__ __forceinline__ void pv_tile(f32x16 (&o)[2], const LAS unsigned char* vb, const v4u (&pw)[4]) {
#pragma unroll
    for (int d0 = 0; d0 < 2; ++d0)
#pragma unroll
        for (int ks = 0; ks < 4; ++ks) {
            const s16x4 lo = vtr(vb + d0 * 4096 + ks * 1024), hi = vtr(vb + d0 * 4096 + ks * 1024 + 512);
            const bf16x8 vf = (bf16x8){lo[0], lo[1], lo[2], lo[3], hi[0], hi[1], hi[2], hi[3]};
            o[d0] = __builtin_amdgcn_mfma_f32_32x32x16_bf16(__builtin_bit_cast(bf16x8, pw[ks]), vf, o[d0], 0, 0, 0);
        }
}

__device__ __forceinline__ void attn_tile(f32x16 (&o)[2], float& m, float& l, const bf16x8 (&qr)[4], f32x16 p0, f32x16 p1,
                                          const LAS unsigned char* Kimg, const LAS unsigned char* Vimg, LAS float* wsf, int r32, int hi) {
    const LAS unsigned char* kb = Kimg + hi * 1024 + r32 * 16;
#pragma unroll
    for (int d0 = 0; d0 < 4; ++d0) {
        const bf16x8 k0 = *(const LAS bf16x8*)(kb + d0 * 2048), k1 = *(const LAS bf16x8*)(kb + d0 * 2048 + 512);
        p0 = __builtin_amdgcn_mfma_f32_32x32x16_bf16(k0, qr[d0], p0, 0, 0, 0);
        p1 = __builtin_amdgcn_mfma_f32_32x32x16_bf16(k1, qr[d0], p1, 0, 0, 0);
    }
    float mt = fmaxf(p0[0], p1[0]);
#pragma unroll
    for (int r = 1; r < 16; ++r) mt = fmaxf(mt, fmaxf(p0[r], p1[r]));
    mt = fmaxf(mt, __shfl_xor(mt, 32));
    if (__any(mt > m)) {
        const float mn = fmaxf(m, mt);
        const float f = __builtin_amdgcn_exp2f((m - mn) * LOG2E);
        m = mn; l *= f;
        if (hi == 0) wsf[r32] = f;
        asm volatile("s_waitcnt lgkmcnt(0)" ::: "memory");
#pragma unroll
        for (int rg = 0; rg < 4; ++rg) { const f32x4 fv = *(const LAS f32x4*)(wsf + 8 * rg + 4 * hi);
#pragma unroll
            for (int e = 0; e < 4; ++e) { o[0][4 * rg + e] *= fv[e]; o[1][4 * rg + e] *= fv[e]; } }
        asm volatile("s_waitcnt lgkmcnt(0)" ::: "memory");
    }
    const float nm = -m * LOG2E;
    float rs = 0.f;
#pragma unroll
    for (int r = 0; r < 16; ++r) { p0[r] = __builtin_amdgcn_exp2f(fmaf(p0[r], LOG2E, nm)); p1[r] = __builtin_amdgcn_exp2f(fmaf(p1[r], LOG2E, nm)); rs += p0[r] + p1[r]; }
    l += rs;
    v4u pw[4];
    pw[0] = (v4u){cvtpk(p0[0], p0[1]), cvtpk(p0[2], p0[3]), cvtpk(p0[4], p0[5]), cvtpk(p0[6], p0[7])};
    pw[1] = (v4u){cvtpk(p0[8], p0[9]), cvtpk(p0[10], p0[11]), cvtpk(p0[12], p0[13]), cvtpk(p0[14], p0[15])};
    pw[2] = (v4u){cvtpk(p1[0], p1[1]), cvtpk(p1[2], p1[3]), cvtpk(p1[4], p1[5]), cvtpk(p1[6], p1[7])};
    pw[3] = (v4u){cvtpk(p1[8], p1[9]), cvtpk(p1[10], p1[11]), cvtpk(p1[12], p1[13]), cvtpk(p1[14], p1[15])};
    const LAS unsigned char* vb = Vimg + ((r32 >> 4) & 1) * 32 + (r32 & 3) * 8 + (4 * hi + ((r32 & 15) >> 2)) * 64;
    pv_tile(o, vb, pw);
}

__device__ __forceinline__ void tile_load(v4u (&t)[4], const bf16* P, int row0, int col0, int lane) {
    const bf16* p = P + (size_t)(row0 + (lane >> 3)) * NIN + col0 + (lane & 7) * 8;
#pragma unroll
    for (int i = 0; i < 4; ++i) t[i] = *(const GAS v4u*)(p + (size_t)i * 8 * NIN);
}
__device__ __forceinline__ void tile_to_elems(unsigned (&e)[16], const v4u (&t)[4], LAS unsigned char* stg, int lane, int r32, int hi) {
#pragma unroll
    for (int i = 0; i < 4; ++i) *(LAS v4u*)(stg + (i * 8 + (lane >> 3)) * 128 + (lane & 7) * 16) = t[i];
    asm volatile("s_waitcnt lgkmcnt(0)" ::: "memory");
#pragma unroll
    for (int r = 0; r < 16; ++r) { const LAS unsigned short* q = (const LAS unsigned short*)(stg + crow(r, hi) * 128) + r32; e[r] = (unsigned)q[0] | ((unsigned)q[32] << 16); }
    asm volatile("s_waitcnt lgkmcnt(0)" ::: "memory");
}
template <bool HAS_U>
__device__ __forceinline__ void wave_epilogue(const f32x16 (&o)[2], bool use_scale, float scale_q, LAS float* wsf, LAS unsigned char* stg, const unsigned (&ze)[16], const unsigned (&ue)[16], bf16* Y, int row0, int ycol, int lane, int r32, int hi) {
    f32x4 sc[4];
    if (use_scale) {
        if (hi == 0) wsf[r32] = scale_q;
        asm volatile("s_waitcnt lgkmcnt(0)" ::: "memory");
#pragma unroll
        for (int rg = 0; rg < 4; ++rg) sc[rg] = *(const LAS f32x4*)(wsf + 8 * rg + 4 * hi);
        asm volatile("s_waitcnt lgkmcnt(0)" ::: "memory");
    } else {
#pragma unroll
        for (int rg = 0; rg < 4; ++rg) sc[rg] = (f32x4){1.f, 1.f, 1.f, 1.f};
    }
#pragma unroll
    for (int r = 0; r < 16; ++r) {
        float v0 = o[0][r] * sc[r >> 2][r & 3] * silu(bfl(ze[r])), v1 = o[1][r] * sc[r >> 2][r & 3] * silu(bfh(ze[r]));
        if (HAS_U) { v0 *= bfl(ue[r]); v1 *= bfh(ue[r]); }
        LAS unsigned short* q = (LAS unsigned short*)(stg + crow(r, hi) * 128) + r32;
        q[0] = (unsigned short)f2bf(v0); q[32] = (unsigned short)f2bf(v1);
    }
    asm volatile("s_waitcnt lgkmcnt(0)" ::: "memory");
    bf16* yp = Y + (size_t)(row0 + (lane >> 3)) * D + ycol + (lane & 7) * 8;
#pragma unroll
    for (int i = 0; i < 4; ++i) { const v4u v = *(const LAS v4u*)(stg + (i * 8 + (lane >> 3)) * 128 + (lane & 7) * 16); *(GAS v4u*)(yp + (size_t)i * 8 * D) = v; }
    asm volatile("s_waitcnt lgkmcnt(0)" ::: "memory");
}

struct AttnUnit {
    int kind;
    int np;
    int T;
    int nct;
    int npc, tps, crs, cps;
    const float* cK; const float* cV; int cpitch;
    int prow0;
    int kcol, vcol;
    int last_valid;
    int dc0;
    bool active; int plane, qrow0, qcol, h, qi0, zcol, ycol; float sink;
};

#define MX_PREFETCH(t_) do { const int t__ = (t_); const int nvalid__ = (t__ == U.T - 1) ? U.last_valid : 64; \
    if (t__ < U.nct) { const float* kp__ = U.cK + (size_t)(t__ * U.crs + kkey) * U.cpitch + kd; const float* vp__ = U.cV + (size_t)(t__ * U.crs + vkey) * U.cpitch + vd; \
        _Pragma("unroll") for (int p = 0; p < 2; ++p) if (p < U.npc) { \
            pre[2 * p][0] = *(const GAS v4u*)(kp__ + (size_t)p * U.cps); pre[2 * p + 1][0] = *(const GAS v4u*)(kp__ + (size_t)p * U.cps + 4); \
            pre[2 * p][1] = *(const GAS v4u*)(vp__ + (size_t)p * U.cps); pre[2 * p + 1][1] = *(const GAS v4u*)(vp__ + (size_t)p * U.cps + 4); } \
    } else { const int pr__ = U.prow0 + (t__ - U.nct) * 64; \
        const bf16* kp__ = F.P() + (size_t)(pr__ + kkey) * NIN + U.kcol + kd; const bf16* vp__ = F.P() + (size_t)(pr__ + vkey) * NIN + U.vcol + vd; \
        _Pragma("unroll") for (int p = 0; p < 4; ++p) if (p < U.np) { \
            pre[p][0] = (kkey < nvalid__) ? *(const GAS v4u*)(kp__ + 64 * p) : (v4u){0u, 0u, 0u, 0u}; \
            pre[p][1] = (vkey < nvalid__) ? *(const GAS v4u*)(vp__ + 64 * p) : (v4u){0u, 0u, 0u, 0u}; } } } while (0)
#define MX_STAGE(t_) do { const int t__ = (t_); LAS unsigned char* dst__ = kv + w * 1024 + lane * 16; \
    if (t__ < U.nct) { \
        _Pragma("unroll") for (int p = 0; p < 2; ++p) if (p < U.npc) { \
            _Pragma("unroll") for (int x = 0; x < 2; ++x) { const v4u a = pre[2 * p][x], b = pre[2 * p + 1][x]; v4u o_; \
                o_.x = cvtpk(u2f(a.x), u2f(a.y)); o_.y = cvtpk(u2f(a.z), u2f(a.w)); \
                o_.z = cvtpk(u2f(b.x), u2f(b.y)); o_.w = cvtpk(u2f(b.z), u2f(b.w)); \
                *(LAS v4u*)(dst__ + p * 16384 + x * 8192) = o_; } } \
    } else { \
        _Pragma("unroll") for (int p = 0; p < 4; ++p) if (p < U.np) { *(LAS v4u*)(dst__ + p * 16384) = pre[p][0]; *(LAS v4u*)(dst__ + p * 16384 + 8192) = pre[p][1]; } } } while (0)

__device__ __forceinline__ void attn_unit(Frame& F, const AttnUnit& U, LAS unsigned char* kv, const LAS float* tabB, const LAS float* tabC, float cconst  ) {
    const int lane = F.lane, w = F.wave, r32 = lane & 31, hi = lane >> 5;
    LAS float* wsf = (LAS float*)(F.lds + WSF_OFF) + w * 64;
    LAS unsigned char* stg = F.lds + STG_OFF + w * 4096;
    v4u zt[4];
    v4u pre[4][2];
    const int kkey = lane, vkey = 16 * (w & 3) + (lane >> 2);
    const int kd = 8 * w, vd = (w >> 2) * 32 + (lane & 3) * 8;
    bf16x8 qr[4]; f32x16 o[2]; float m, l;
    o[0] = (f32x16){}; o[1] = (f32x16){};
    const int qi = U.qi0 + r32;
    if (U.active) {
        tile_load(zt, F.P(), U.qrow0, U.zcol, lane);
        const bf16* qp = F.P() + (size_t)(U.qrow0 + r32) * NIN + U.qcol + 8 * hi;
#pragma unroll
        for (int d0 = 0; d0 < 4; ++d0) { const v4u x = *(const GAS v4u*)(qp + 16 * d0);
            v4u y; y.x = cvtpk(bfl(x.x) * 0.125f, bfh(x.x) * 0.125f); y.y = cvtpk(bfl(x.y) * 0.125f, bfh(x.y) * 0.125f); y.z = cvtpk(bfl(x.z) * 0.125f, bfh(x.z) * 0.125f); y.w = cvtpk(bfl(x.w) * 0.125f, bfh(x.w) * 0.125f);
            qr[d0] = __builtin_bit_cast(bf16x8, y); }
    } else {
#pragma unroll
        for (int d0 = 0; d0 < 4; ++d0) qr[d0] = (bf16x8){};
#pragma unroll
        for (int i = 0; i < 4; ++i) zt[i] = (v4u){0u, 0u, 0u, 0u};
    }
    if (U.kind == 0) { m = U.sink; l = (hi == 0) ? 1.f : 0.f; } else { m = -1e30f; l = 0.f; }
    const int cp = (qi + 1) & 1;
    const LAS float* ltab = (U.kind == 0 ? tabB : tabC) + (U.h * 2 + cp) * TABW + (191 - qi + 4 * hi + cp);
    MX_PREFETCH(0);
    for (int t = 0; t < U.T; ++t) {
        __syncthreads();
        MX_STAGE(t);
        __syncthreads();
        if (t + 1 < U.T) MX_PREFETCH(t + 1);
        if (U.active) {
            const bool cst = t < U.nct;
            const int ntl = cst ? U.tps : 1;
            for (int tp = 0; tp < ntl; ++tp) {
                const int dc = cst ? U.dc0 + t * U.tps + tp : U.dc0 + U.nct * U.tps + (t - U.nct);
                const int plane = (cst && U.tps == 2) ? tp : U.plane;
                f32x16 p0, p1;
                if (dc >= -2) {
                    const LAS float* tp_ = ltab + dc * 64;
#pragma unroll
                    for (int rg = 0; rg < 4; ++rg)
#pragma unroll
                        for (int pp = 0; pp < 2; ++pp) { const f32x2 a = *(const LAS f32x2*)(tp_ + 8 * rg + 2 * pp), b = *(const LAS f32x2*)(tp_ + 32 + 8 * rg + 2 * pp);
                            p0[4 * rg + 2 * pp] = a.x; p0[4 * rg + 2 * pp + 1] = a.y; p1[4 * rg + 2 * pp] = b.x; p1[4 * rg + 2 * pp + 1] = b.y; }
                } else {
#pragma unroll
                    for (int r = 0; r < 16; ++r) { p0[r] = cconst; p1[r] = cconst; }
                }
                if (t == U.T - 1 && U.last_valid == 32) {
#pragma unroll
                    for (int r = 0; r < 16; ++r) p1[r] = -1e30f;
                }
                attn_tile(o, m, l, qr, p0, p1, kv + plane * 16384, kv + plane * 16384 + 8192, wsf, r32, hi);
            }
        }
    }
    if (U.active) {
        l += __shfl_xor(l, 32);
        unsigned ze[16]; tile_to_elems(ze, zt, stg, lane, r32, hi);
        wave_epilogue<false>(o, true, 1.f / l, wsf, stg, ze, ze, F.Y(), U.qrow0, U.ycol, lane, r32, hi);
    }
}

__device__ __forceinline__ void mixa_unit(Frame& F, const Args& A, int layer, int row0, int T, float* avs  , LAS unsigned char* kv) {
    const int lane = F.lane, w = F.wave, r32 = lane & 31, hi = lane >> 5;
    __syncthreads();
    {
        const f32x4 ga = *(const GAS f32x4*)(A.in[10] + (size_t)layer * 256 + 4 * lane);
        const int g = lane >> 4, cg = 4 * (lane & 15);
        const int TS = T < 64 ? 64 : T;
        u32x2 xr[16];
#pragma unroll
        for (int k = 0; k < 16; ++k) { const int s = w + 8 * k; xr[k] = (s < T) ? *(const GAS u32x2*)(F.P() + (size_t)(row0 + s) * NIN + PC_AV + 4 * lane) : (u32x2){0u, 0u}; }
#pragma unroll
        for (int k = 0; k < 16; ++k) {
            const int s = w + 8 * k;
            if (s < TS) {
                LAS u32x2* dst = (LAS u32x2*)(kv + g * 16384 + (s >> 6) * 8192 + (cg >> 5) * 4096 + (s & 63) * 64 + (cg & 31) * 2);
                if (s < T) {
                    const u32x2 x = xr[k];
                    float a = bfl(x.x), b = bfh(x.x), c = bfl(x.y), d = bfh(x.y);
                    const float rstd = 1.f / sqrtf(wave_sum((a * a + b * b) + (c * c + d * d)) * (1.f / 256.f) + RMS_EPS);
                    a *= rstd * ga.x; b *= rstd * ga.y; c *= rstd * ga.z; d *= rstd * ga.w;
                    if (avs) *(GAS f32x4*)(avs + (size_t)s * 256 + 4 * lane) = (f32x4){a, b, c, d};
                    *dst = (u32x2){cvtpk(a, b), cvtpk(c, d)};
                } else *dst = (u32x2){0u, 0u};
            }
        }
    }
    __syncthreads();
    const int g = w >> 1;
    const bf16* Wg = F.Wtril() + (size_t)(layer * 4 + g) * 128 * 128;
    const float* bsg = A.in[12] + (size_t)(layer * 4 + g) * 128;
    for (int i = 0; i < 2; ++i) {
        const int tb = 2 * (w & 1) + i;
        if (tb * 32 >= T) break;
        f32x16 o[2];
        v4u zt[4], ut[4]; tile_load(zt, F.P(), row0 + tb * 32, PC_AZ + g * 64, lane); tile_load(ut, F.P(), row0 + tb * 32, PC_AU + g * 64, lane);
#pragma unroll
        for (int rg = 0; rg < 4; ++rg) { const f32x4 bv = *(const GAS f32x4*)(bsg + tb * 32 + 8 * rg + 4 * hi);
#pragma unroll
            for (int e = 0; e < 4; ++e) { o[0][4 * rg + e] = bv[e]; o[1][4 * rg + e] = bv[e]; } }
        const int nst = (tb >= 2) ? 2 : 1;
        for (int st = 0; st < nst; ++st) {
            v4u pw[4];
            const bf16* wp = Wg + (size_t)(tb * 32 + r32) * 128 + st * 64 + 4 * hi;
#pragma unroll
            for (int ks = 0; ks < 4; ++ks) { const u32x2 a = *(const GAS u32x2*)(wp + 16 * ks), b = *(const GAS u32x2*)(wp + 16 * ks + 8); pw[ks] = (v4u){a.x, a.y, b.x, b.y}; }
            const LAS unsigned char* vb = kv + g * 16384 + st * 8192 + ((r32 >> 4) & 1) * 32 + (r32 & 3) * 8 + (4 * hi + ((r32 & 15) >> 2)) * 64;
            pv_tile(o, vb, pw);
        }
        LAS unsigned char* stg = F.lds + STG_OFF + w * 4096;
        unsigned ze[16], ue[16]; tile_to_elems(ze, zt, stg, lane, r32, hi); tile_to_elems(ue, ut, stg, lane, r32, hi);
        wave_epilogue<true>(o, false, 1.f, nullptr, stg, ze, ue, F.Y(), row0 + tb * 32, YC_A + g * 64, lane, r32, hi);
    }
}
}

#ifndef MIX_MASK
#define MIX_MASK 63
#endif
#ifndef MIX_REP
#define MIX_REP 0
#endif
constexpr int MU_CP = 256, MU_CS = 128, MU_BS = 32, MU_BP = 512, MU_AP = 128, MU_AS = 32;
constexpr int MU_TOTAL = MU_CP + MU_CS + MU_BS + MU_BP + MU_AP + MU_AS;
constexpr int MU_GROUP = MU_TOTAL / 8;
constexpr int CW_Q = 8192;
__device__ __forceinline__ void mix_phase(Frame& F0, const Args& A, int layer) {
    Frame F = F0;
    { int tid = threadIdx.x; asm volatile("" : "+v"(tid)); F.tid = tid; F.lane = tid & 63; F.wave = __builtin_amdgcn_readfirstlane(tid >> 6); }
    LAS unsigned char* kv = F.lds + KV_OFF;
    LAS float* tabB = (LAS float*)(F.lds + TABB_OFF); LAS float* tabC = (LAS float*)(F.lds + TABC_OFF);
    volatile LAS unsigned* slot = (volatile LAS unsigned*)(F.lds + LDSCTL_OFF);
    __syncthreads();
    for (int i = F.tid; i < 8 * 2 * mx::TABW; i += NWAVES * 64) { const int h = i / (2 * mx::TABW), cp = (i / mx::TABW) & 1, rel = (i % mx::TABW) - cp - 191;
        tabB[i] = (rel >= -191 && rel <= 63) ? A.in[15][t5_bucket(rel) * 8 + h] : 0.f; }
    for (int i = F.tid; i < 4 * 2 * mx::TABW; i += NWAVES * 64) { const int h = i / (2 * mx::TABW), cp = (i / mx::TABW) & 1, rel = (i % mx::TABW) - cp - 191;
        const int ci = (rel < -128 ? -128 : (rel > 128 ? 128 : rel)) + 128; tabC[i] = A.in[14][((size_t)layer * 257 + ci) * 4 + h]; }
    const int w = F.wave;
    const int grp = (F.vcu * 8) / F.G;
    gu32* qctr = (gu32*)(F.ws + WS_CTL) + CW_Q + (layer * 8 + grp) * 64;
    for (;;) {
        __syncthreads();
        if (F.tid == 0) *slot = __hip_atomic_fetch_add(qctr, 1u, __ATOMIC_RELAXED, __HIP_MEMORY_SCOPE_AGENT);
        __syncthreads();
        const int idx = (int)*slot;
        if (idx >= MU_GROUP) break;
        const int b = grp;
        if (idx < 16 || (idx >= 16 && idx < 48) || (idx >= 64 && idx < 132)) {
            mx::AttnUnit U; U.cK = nullptr; U.cV = nullptr; U.cpitch = 0; U.nct = 0; U.last_valid = 64; U.sink = 0.f; U.npc = 0; U.tps = 1; U.crs = 64; U.cps = 64; float cconst = 0.f;
            int ty;
            if (idx < 16) { ty = 1; const int h = idx & 3, s = 4 * grp + (idx >> 2);
                U.kind = 1; U.np = 1; U.T = 5; U.nct = 4; U.npc = 2; U.tps = 2; U.crs = 128; U.cps = 64 * 256;
                U.cK = A.in[4] + ((size_t)(layer * 32 + s) * 512) * 256 + h * 64; U.cV = A.in[5] + ((size_t)(layer * 32 + s) * 512) * 256 + h * 64; U.cpitch = 256;
                U.prow0 = NPROMPT + s * 32; U.kcol = PC_CK + h * 64; U.vcol = PC_CV + h * 64; U.last_valid = 32; U.dc0 = -8;
                U.active = (w == 0); U.plane = 0; U.qrow0 = NPROMPT + s * 32; U.qcol = PC_CQ + h * 64; U.h = h; U.qi0 = 0; U.zcol = PC_CZ + h * 64; U.ycol = YC_C + h * 64;
                cconst = A.in[14][((size_t)layer * 257) * 4 + h]; }
            else if (idx < 48) { ty = 0; const int n = 31 - (idx - 16); const int c0 = n >= 8 ? n - 8 : 0; const int h = w >> 1;
                U.kind = 1; U.np = 4; U.T = n - c0 + 1; U.prow0 = b * SEQ + c0 * 64; U.kcol = PC_CK; U.vcol = PC_CV; U.dc0 = c0 - n;
                U.active = true; U.plane = h; U.qrow0 = b * SEQ + n * 64 + (w & 1) * 32; U.qcol = PC_CQ + h * 64; U.h = h; U.qi0 = (w & 1) * 32; U.zcol = PC_CZ + h * 64; U.ycol = YC_C + h * 64;
                cconst = A.in[14][((size_t)layer * 257) * 4 + h]; }
            else if (idx < 128) { ty = 3; const int k = idx - 64; const int kvh = k & 1, n = 31 - (k >> 1); const int c0 = n >= 2 ? n - 2 : 0; const int h = kvh * 4 + (w >> 1);
                U.kind = 0; U.np = 1; U.T = n - c0 + 1; U.prow0 = b * SEQ + c0 * 64; U.kcol = PC_BK + kvh * 64; U.vcol = PC_BV + kvh * 64; U.dc0 = c0 - n;
                U.active = true; U.plane = 0; U.qrow0 = b * SEQ + n * 64 + (w & 1) * 32; U.qcol = PC_BQ + h * 64; U.h = h; U.qi0 = (w & 1) * 32; U.zcol = PC_BZ + h * 64; U.ycol = YC_B + h * 64; U.sink = A.in[13][layer * 8 + h]; }
            else { ty = 2; const int s = 4 * grp + (idx - 128); const int h = w;
                U.kind = 0; U.np = 2; U.T = 3; U.nct = 2; U.npc = 2; U.tps = 1; U.crs = 64; U.cps = 64;
                U.cK = A.in[2] + ((size_t)(layer * 32 + s) * 128) * 128; U.cV = A.in[3] + ((size_t)(layer * 32 + s) * 128) * 128; U.cpitch = 128;
                U.prow0 = NPROMPT + s * 32; U.kcol = PC_BK; U.vcol = PC_BV; U.last_valid = 32; U.dc0 = -2;
                U.active = true; U.plane = h >> 2; U.qrow0 = NPROMPT + s * 32; U.qcol = PC_BQ + h * 64; U.h = h; U.qi0 = 0; U.zcol = PC_BZ + h * 64; U.ycol = YC_B + h * 64; U.sink = A.in[13][layer * 8 + h]; }
            (void)ty;
            mx::attn_unit(F, U, kv, tabB, tabC, cconst);
        } else if (idx < 64) { const int n = idx - 48; mx::mixa_unit(F, A, layer, b * SEQ + n * 128, 128, nullptr, kv); }
        else { const int s = 4 * grp + (idx - 132); mx::mixa_unit(F, A, layer, NPROMPT + s * 32, 32, F.out + O_AVS + ((size_t)layer * NSAMP + s * 32) * 256, kv); }
    }
    __syncthreads();
}
constexpr int N_PHASES = 1 + 4 * DEPTH;
__global__ void __launch_bounds__(NWAVES * 64, 2) mk_fwd(Args args) {
    extern __shared__ __attribute__((aligned(16))) unsigned char lds[];
    Frame F;
    F.lds = (LAS unsigned char*)lds;
    F.tid = 0; F.lane = 0; F.wave = 0;
    F.G = gridDim.x; { const int bx = blockIdx.x; F.vcu = (F.G % 8 == 0) ? (bx % 8) * (F.G / 8) + bx / 8 : bx; }
    F.ws = args.ws; F.out = args.out;
    for (int u = threadIdx.x; u < (LDS_BYTES - LDSCTL_OFF) / 4; u += NWAVES * 64) ((LAS unsigned*)(F.lds + LDSCTL_OFF))[u] = 0u;
    __syncthreads();
    const int lo = args.ph_lo, hi = args.ph_hi;
    const bool multi = (hi - lo) > 1;
    XcdBarrier bar; bar.bar = (unsigned*)(F.ws + WS_CTL) + CW_BAR; bar.x = 0; bar.st = nullptr;
    if (multi) bar = xcd_barrier_post((unsigned*)(F.ws + WS_CTL) + CW_BAR, (volatile LAS unsigned*)(F.lds + MISC_OFF) + 8);
#define IN(k) (lo <= (k) && (k) < hi)
#define SEAM(k) do { if (IN(k) && IN((k) + 1)) xcd_barrier(bar); } while (0)
    if (IN(0)) { p0_prologue(F, args); SEAM(0); }
    for (int layer = 0; layer < DEPTH; ++layer) {
        const int p0 = 1 + 4 * layer;
        if (IN(p0)) {
            pg8::Gemm g{F.XN(), F.Win_t() + (size_t)layer * NIN * D, M, NIN, D}; pg8::StaticOrder S; S.init(M, NIN, F.G, (int)blockIdx.x);
            pg8::EpiP E{F.P(), F.out, layer};
            pg8::gemm_phase<pg8::EpiP, pg8::StaticOrder, true, true>(F.lds + RING_OFF, g, S, E);
            SEAM(p0);
        }
        if (IN(p0 + 1)) { mix_phase(F, args, layer); SEAM(p0 + 1); }
        if (IN(p0 + 2)) {
            pg8::Gemm g{F.Y(), F.Wout_t() + (size_t)layer * D * D, M, D, D}; pg8::StaticOrder S; S.init(M, D, F.G, (int)blockIdx.x);
            pg8::EpiF32 E{F.YF(), D};
            pg8::gemm_phase<pg8::EpiF32, pg8::StaticOrder, true, true>(F.lds + RING_OFF, g, S, E);
            SEAM(p0 + 2);
        }
        if (IN(p0 + 3)) { post_phase(F, args, layer); SEAM(p0 + 3); }
    }
#undef IN
#undef SEAM
}

constexpr int MIXK_LDS = 4 * 16384 + 1024 + 4352;
__global__ void __launch_bounds__(256) mix_simple_kernel(Args args, int layer) {
    __shared__ __attribute__((aligned(16))) unsigned char lds_m[MIXK_LDS];
    Frame F;
    F.lds = (LAS unsigned char*)lds_m;
    F.tid = threadIdx.x; F.lane = F.tid & 63; F.wave = __builtin_amdgcn_readfirstlane(F.tid >> 6);
    F.G = gridDim.x; F.vcu = blockIdx.x;
    F.ws = args.ws; F.out = args.out;
    mix_phase_simple<4>(F, args, layer);
}

#ifndef MK_SINGLE
#define MK_SINGLE 1
#endif
extern "C" void kernel_launch(void* const* d_in, const int* in_sizes, int n_in, void* d_out, int out_size, void* d_ws, size_t ws_size, hipStream_t stream) {
    static int grid = 0;
    if (grid == 0) {
        if (n_in != 16 || out_size != (int)O_END || ws_size < WS_END) { fprintf(stderr, "kernel_launch: unexpected shapes: n_in %d out %d ws %zu\n", n_in, out_size, ws_size); grid = -1; return; }
        int dev = 0, cus = 0;
        if (hipGetDevice(&dev) != hipSuccess || hipDeviceGetAttribute(&cus, hipDeviceAttributeMultiprocessorCount, dev) != hipSuccess) { grid = -1; return; }
        if (hipFuncSetAttribute((const void*)mk_fwd, hipFuncAttributeMaxDynamicSharedMemorySize, LDS_BYTES) != hipSuccess) { fprintf(stderr, "kernel_launch: hipFuncSetAttribute failed\n"); grid = -1; return; }
        (void)hipGetLastError();
        grid = cus;
    }
    if (grid < 0) return;
    (void)hipMemsetAsync((char*)d_ws + WS_CTL, 0, CTL_ZERO_BYTES, stream);
    Args a{};
    for (int i = 0; i < 16; ++i) a.in[i] = (const float*)d_in[i];
    a.out = (float*)d_out; a.ws = (unsigned char*)d_ws;
#if MK_SINGLE
    a.ph_lo = 0; a.ph_hi = N_PHASES;
    hipLaunchKernelGGL(mk_fwd, dim3(grid), dim3(NWAVES * 64), LDS_BYTES, stream, a);
#else
    for (int ph = 0; ph < N_PHASES; ++ph) {
#if MIX_MASK != 63
        if (ph >= 1 && ((ph - 1) & 3) == 1) hipLaunchKernelGGL(mix_simple_kernel, dim3(1024), dim3(256), 0, stream, a, (ph - 1) >> 2);
#endif
        a.ph_lo = ph; a.ph_hi = ph + 1; hipLaunchKernelGGL(mk_fwd, dim3(grid), dim3(NWAVES * 64), LDS_BYTES, stream, a); }
#endif
}
```
